# Optimizing an MI355X kernel written in HIP

```python
import math
import jax
import jax.numpy as jnp
from jax import lax
import numpy as np


D_MODEL = 2048
BATCH = 4
SEQ = 4096
DEPTH = 4

GRID_W = 64
CTX_LEN = 256
HEAD_DIM = 128
HY_WIDTH = D_MODEL // 2
HY_ORDER = 2
HY_EMB = 33
HY_BANDS = (HY_EMB - 1) // 2
HY_FILTER_HIDDEN = 64
HY_FAST_DECAY = 0.3
HY_SLOW_DECAY = 1.5
HY_DECAY_TARGET = 1e-2
HY_MAX_DECAY = math.log(HY_DECAY_TARGET) / HY_FAST_DECAY
HY_MIN_DECAY = math.log(HY_DECAY_TARGET) / HY_SLOW_DECAY
NA_HEADS = D_MODEL // (4 * HEAD_DIM)
NA_WIN_R = 8
NA_WIN_C = 16
GQA_Q_HEADS = D_MODEL // (4 * HEAD_DIM)
GQA_KV_HEADS = GQA_Q_HEADS // 2
GQA_GROUP = GQA_Q_HEADS // GQA_KV_HEADS
GQA_WINDOW = 128
GQA_BLOCK = 128
ROPE_BASE = 10000.0
D_FF = 5632
N_BRANCH = 3
NORM_EPS = 1e-6
NA_W = NA_HEADS * HEAD_DIM
GQA_QW = GQA_Q_HEADS * HEAD_DIM
GQA_KVW = GQA_KV_HEADS * HEAD_DIM
MIX_WIDTH = HY_WIDTH + NA_W + GQA_QW
KV_COLS = 2 * NA_W + 2 * GQA_KVW
IN_SIZES = (NA_W, NA_W, GQA_KVW, GQA_KVW, 3 * HY_WIDTH, NA_W, GQA_QW, N_BRANCH * D_MODEL)
N_IN = sum(IN_SIZES)

kernel_name = 'hybrid_hyena_natten_swa_dit_block'

F32 = jnp.float32
NEG_INF = -1e30


def _split(a, sizes, axis=-1):
    out, o = [], 0
    for n in sizes:
        out.append(lax.slice_in_dim(a, o, o + n, axis=axis))
        o += n
    return out


def _heads(t, n):
    return t.reshape(t.shape[:-1] + (n, HEAD_DIM))


def rms_norm(x, g):
    xf = x.astype(F32)
    y = xf * lax.rsqrt(jnp.mean(xf * xf, axis=-1, keepdims=True) + NORM_EPS)
    return (y * g.astype(F32)).astype(x.dtype)


def modulate(xn, shift, scale):
    return xn * (1 + scale) + shift


def dwconv3(x, w, b):
    xp = jnp.pad(x, ((0, 0), (1, 1), (0, 0)))
    return xp[:, :-2] * w[0] + xp[:, 1:-1] * w[1] + xp[:, 2:] * w[2] + b


def axial_rope_tables(n):
    t = jnp.arange(n)
    row = (t // GRID_W).astype(F32)
    col = (t % GRID_W).astype(F32)
    per_axis = HEAD_DIM // 2
    inv = ROPE_BASE ** (-jnp.arange(0, per_axis, 2, dtype=F32) / per_axis)
    ang = jnp.stack([row[:, None] * inv, col[:, None] * inv], axis=1)
    return jnp.cos(ang), jnp.sin(ang)


def apply_axial_rope(x, cos, sin):
    qd = HEAD_DIM // 4
    n = x.shape[1]
    shp = (1, n) + (1,) * (x.ndim - 3) + (2, qd)
    c, s = cos.reshape(shp), sin.reshape(shp)
    xr = x.astype(F32).reshape(x.shape[:-1] + (2, 2, qd))
    x1, x2 = xr[..., 0, :], xr[..., 1, :]
    out = jnp.stack([x1 * c - x2 * s, x2 * c + x1 * s], axis=-2)
    return out.reshape(x.shape).astype(x.dtype)


def hyena_filters(n, w1, b1, freq, w2, b2, w3):
    t = jnp.linspace(0.0, 1.0, n, dtype=F32)[:, None]
    w = (2.0 * math.pi / n) * jnp.arange(n, dtype=F32)[:, None]
    f = jnp.linspace(1e-4, HY_BANDS - 1, HY_BANDS, dtype=F32)[None, :]
    z = jnp.concatenate([t, jnp.cos(f * w), -jnp.sin(f * w)], axis=-1)
    a = jnp.sin(freq[0].astype(F32) * (z @ w1.astype(F32) + b1.astype(F32)))
    a = jnp.sin(freq[1].astype(F32) * (a @ w2.astype(F32) + b2.astype(F32)))
    hf = (a @ w3.astype(F32)).reshape(n, 2, HY_ORDER * HY_WIDTH)
    deltas = jnp.linspace(HY_MIN_DECAY, HY_MAX_DECAY, HY_ORDER * HY_WIDTH, dtype=F32)
    hf = hf * jnp.exp(-t[:, :, None] * jnp.abs(deltas))
    fwd, bwd = hf[:, 0], hf[:, 1]
    k = jnp.concatenate([fwd, jnp.zeros_like(fwd[:1]), bwd[:0:-1]], axis=0)
    k = k / jnp.sum(jnp.abs(k), axis=0, keepdims=True)
    return k.reshape(2 * n, HY_ORDER, HY_WIDTH)


def hyena_mixer(u, conv_w, conv_b, w1, b1, freq, w2, b2, w3, skip):
    n = u.shape[1]
    u = dwconv3(u, conv_w, conv_b)
    v, x1, x2 = jnp.split(u.astype(F32), 3, axis=-1)
    kf = jnp.fft.rfft(hyena_filters(n, w1, b1, freq, w2, b2, w3), axis=0)

    def long_conv(z, o):
        zf = jnp.fft.rfft(z, n=2 * n, axis=1)
        y = jnp.fft.irfft(zf * kf[None, :, o], n=2 * n, axis=1)[:, :n]
        return y + skip[o].astype(F32) * z

    z = x1 * long_conv(v, 0)
    y = x2 * long_conv(z, 1)
    return y.astype(u.dtype)


def na_latent(q, k, v, k_ctx, v_ctx, rpb):
    b, s, h, d = q.shape
    rows = s // GRID_W
    kr = min(NA_WIN_R, rows)
    kc = NA_WIN_C
    r = jnp.arange(rows)
    row_idx = jnp.clip(r - kr // 2, 0, rows - kr)[:, None] + jnp.arange(kr)[None, :]
    cidx = jnp.arange(GRID_W)
    col_start = jnp.clip(cidx - kc // 2, 0, GRID_W - kc)
    col_ok = (cidx[None, :] >= col_start[:, None]) & (cidx[None, :] < col_start[:, None] + kc)
    qg = q.reshape(b, rows, GRID_W, h, d)
    kg = k.reshape(b, rows, GRID_W, h, d)[:, row_idx]
    vg = v.reshape(b, rows, GRID_W, h, d)[:, row_idx]
    scale = HEAD_DIM ** -0.5
    s_loc = jnp.einsum('brqhd,brikhd->brhqik', qg, kg).astype(F32) * scale
    dr = row_idx - r[:, None] + (NA_WIN_R - 1)
    dc = jnp.clip(cidx[None, :] - cidx[:, None] + (NA_WIN_C - 1), 0, 2 * NA_WIN_C - 2)
    bias = rpb.astype(F32)[:, dr[:, None, :, None], dc[None, :, None, :]]
    s_loc = jnp.where(col_ok[:, None, :], s_loc + jnp.moveaxis(bias, 0, 1)[None], NEG_INF)
    s_ctx = jnp.einsum('brqhd,bchd->brhqc', qg, k_ctx).astype(F32) * scale
    nloc = kr * GRID_W
    p = jax.nn.softmax(jnp.concatenate([s_loc.reshape(b, rows, h, GRID_W, nloc), s_ctx], axis=-1), axis=-1)
    p_loc = p[..., :nloc].reshape(b, rows, h, GRID_W, kr, GRID_W).astype(v.dtype)
    p_ctx = p[..., nloc:].astype(v.dtype)
    out = jnp.einsum('brhqik,brikhd->brqhd', p_loc, vg) + jnp.einsum('brhqc,bchd->brqhd', p_ctx, v_ctx)
    return out.reshape(b, s, h * d)


def swa_latent(q, k, v, k_ctx, v_ctx, sink):
    b, s, hk, g, d = q.shape
    bl = GQA_BLOCK
    nb = s // bl
    qb = q.reshape(b, nb, bl, hk, g, d)

    def band(t):
        tp = jnp.pad(t, ((0, 0), (bl, bl), (0, 0), (0, 0))).reshape(b, nb + 2, bl, hk, d)
        return jnp.concatenate([tp[:, :-2], tp[:, 1:-1], tp[:, 2:]], axis=2)

    kb, vb = band(k), band(v)
    blk = jnp.arange(nb)[:, None, None] * bl
    qpos = blk + jnp.arange(bl)[None, :, None]
    kpos = blk + jnp.arange(3 * bl)[None, None, :] - bl
    ok = (jnp.abs(qpos - kpos) <= GQA_WINDOW) & (kpos >= 0) & (kpos < s)
    scale = HEAD_DIM ** -0.5
    s_loc = jnp.einsum('bnqhgd,bnkhd->bnhgqk', qb, kb).astype(F32) * scale
    s_loc = jnp.where(ok[None, :, None, None], s_loc, NEG_INF)
    s_ctx = jnp.einsum('bnqhgd,bchd->bnhgqc', qb, k_ctx).astype(F32) * scale
    sk = jnp.broadcast_to(sink.astype(F32).reshape(1, 1, hk, g, 1, 1), s_loc.shape[:-1] + (1,))
    p = jax.nn.softmax(jnp.concatenate([s_loc, s_ctx, sk], axis=-1), axis=-1)
    n_ctx = k_ctx.shape[1]
    p_loc = p[..., :3 * bl].astype(v.dtype)
    p_ctx = p[..., 3 * bl:3 * bl + n_ctx].astype(v.dtype)
    out = jnp.einsum('bnhgqk,bnkhd->bnqhgd', p_loc, vb) + jnp.einsum('bnhgqc,bchd->bnqhgd', p_ctx, v_ctx)
    return out.reshape(b, s, hk * g * d)


def dense_ctx_attn(q, k, v, sink):
    b, n, hk, g, d = q.shape
    sc = jnp.einsum('bqhgd,bkhd->bhgqk', q, k).astype(F32) * (HEAD_DIM ** -0.5)
    if sink is not None:
        sk = jnp.broadcast_to(sink.astype(F32).reshape(1, hk, g, 1, 1), sc.shape[:-1] + (1,))
        sc = jnp.concatenate([sc, sk], axis=-1)
    p = jax.nn.softmax(sc, axis=-1)[..., :n].astype(v.dtype)
    return jnp.einsum('bhgqk,bkhd->bqhgd', p, v).reshape(b, n, hk * g * d)


def merge_branches(gate_logits, y_hy, y_na, y_sw, w_branch, w_out):
    g_hy, g_na, g_sw = jnp.split(jax.nn.sigmoid(gate_logits.astype(F32)).astype(y_hy.dtype), N_BRANCH, axis=-1)
    wb_hy, wb_na, wb_sw = _split(w_branch, (HY_WIDTH, NA_W, GQA_QW), axis=0)
    m = g_hy * (y_hy @ wb_hy) + g_na * (y_na @ wb_na) + g_sw * (y_sw @ wb_sw)
    return m @ w_out


def context_kv(hc, w_in):
    na_k, na_v, sw_k, sw_v = _split(hc @ w_in[:, :KV_COLS], IN_SIZES[:4])
    return (_heads(na_k, NA_HEADS), _heads(na_v, NA_HEADS), _heads(sw_k, GQA_KV_HEADS), _heads(sw_v, GQA_KV_HEADS))


def latent_mixers(h, kv_c, w_in, hy_p, rpb, sink, w_branch, w_out, cos, sin):
    b, s, _ = h.shape
    na_k, na_v, sw_k, sw_v, hy_u, na_q, sw_q, gates = _split(h @ w_in, IN_SIZES)
    na_kc, na_vc, sw_kc, sw_vc = kv_c
    y_hy = hyena_mixer(hy_u, *hy_p)
    y_na = na_latent(_heads(na_q, NA_HEADS), _heads(na_k, NA_HEADS), _heads(na_v, NA_HEADS), na_kc, na_vc, rpb)
    q = apply_axial_rope(sw_q.reshape(b, s, GQA_KV_HEADS, GQA_GROUP, HEAD_DIM), cos, sin)
    k = apply_axial_rope(_heads(sw_k, GQA_KV_HEADS), cos, sin)
    y_sw = swa_latent(q, k, _heads(sw_v, GQA_KV_HEADS), sw_kc, sw_vc, sink)
    return merge_branches(gates, y_hy, y_na, y_sw, w_branch, w_out)


def context_mixers(hc, kv_c, w_in, hy_p, sink, w_branch, w_out):
    b, n, _ = hc.shape
    hy_u, na_q, sw_q, gates = _split(hc @ w_in[:, KV_COLS:], IN_SIZES[4:])
    na_kc, na_vc, sw_kc, sw_vc = kv_c
    y_hy = hyena_mixer(hy_u, *hy_p)
    y_na = dense_ctx_attn(_heads(na_q, NA_HEADS)[:, :, :, None, :], na_kc, na_vc, None)
    y_sw = dense_ctx_attn(sw_q.reshape(b, n, GQA_KV_HEADS, GQA_GROUP, HEAD_DIM), sw_kc, sw_vc, sink)
    return merge_branches(gates, y_hy, y_na, y_sw, w_branch, w_out)


def conv_glu(h, w_up, conv_w, conv_b, w_down):
    a, u = jnp.split(h @ w_up, 2, axis=-1)
    return (jax.nn.silu(dwconv3(a, conv_w, conv_b)) * u) @ w_down


def setup_inputs(seed: int = 0) -> dict:
    key = jax.random.key(seed)
    ks = jax.random.split(key, 32)
    L, D = DEPTH, D_MODEL

    def nrm(k, shape, s):
        return jax.random.normal(k, shape, jnp.float32) * s

    return {
        'x': nrm(ks[0], (BATCH, SEQ, D), 1.0),
        'c': nrm(ks[1], (BATCH, D), 1.0),
        'ctx': nrm(ks[2], (BATCH, CTX_LEN, D), 1.0),
        'c_ctx': nrm(ks[3], (D,), 1.0),
        'w_mod': nrm(ks[4], (L, D, 6 * D), 0.5 * D ** -0.5),
        'b_mod': nrm(ks[5], (L, 6 * D), 0.02),
        'norm_gains': 1.0 + nrm(ks[6], (L, 4, D), 0.02),
        'w_in': nrm(ks[7], (L, D, N_IN), D ** -0.5),
        'hy_conv_w': nrm(ks[8], (L, 3, 3 * HY_WIDTH), 3 ** -0.5),
        'hy_conv_b': nrm(ks[9], (L, 3 * HY_WIDTH), 0.02),
        'hy_w1': nrm(ks[10], (L, HY_EMB, HY_FILTER_HIDDEN), HY_EMB ** -0.5),
        'hy_b1': nrm(ks[11], (L, HY_FILTER_HIDDEN), 0.02),
        'hy_freq': 1.0 + nrm(ks[12], (L, 2, HY_FILTER_HIDDEN), 0.02),
        'hy_w2': nrm(ks[13], (L, HY_FILTER_HIDDEN, HY_FILTER_HIDDEN), HY_FILTER_HIDDEN ** -0.5),
        'hy_b2': nrm(ks[14], (L, HY_FILTER_HIDDEN), 0.02),
        'hy_w3': nrm(ks[15], (L, HY_FILTER_HIDDEN, 2 * HY_ORDER * HY_WIDTH), HY_FILTER_HIDDEN ** -0.5),
        'hy_skip': nrm(ks[16], (L, HY_ORDER, HY_WIDTH), 0.1),
        'na_rpb': nrm(ks[17], (L, NA_HEADS, 2 * NA_WIN_R - 1, 2 * NA_WIN_C - 1), 0.1),
        'swa_sink': nrm(ks[18], (L, GQA_Q_HEADS), 0.5),
        'w_branch': jnp.concatenate([nrm(ks[19], (L, HY_WIDTH, D), HY_WIDTH ** -0.5),
                                     nrm(ks[20], (L, NA_W, D), NA_W ** -0.5),
                                     nrm(ks[21], (L, GQA_QW, D), GQA_QW ** -0.5)], axis=1),
        'w_out': nrm(ks[22], (L, D, D), D ** -0.5),
        'ffn_w_up': nrm(ks[23], (L, D, 2 * D_FF), D ** -0.5),
        'ffn_conv_w': nrm(ks[24], (L, 3, D_FF), 3 ** -0.5),
        'ffn_conv_b': nrm(ks[25], (L, D_FF), 0.02),
        'ffn_w_down': nrm(ks[26], (L, D_FF, D), D_FF ** -0.5),
    }


def reference(x, c, ctx, c_ctx, w_mod, b_mod, norm_gains, w_in, hy_conv_w, hy_conv_b, hy_w1, hy_b1,
              hy_freq, hy_w2, hy_b2, hy_w3, hy_skip, na_rpb, swa_sink, w_branch, w_out,
              ffn_w_up, ffn_conv_w, ffn_conv_b, ffn_w_down):
    cos, sin = axial_rope_tables(x.shape[1])
    xc = ctx
    silu_c = jax.nn.silu(c)
    silu_cc = jax.nn.silu(c_ctx)
    for l in range(DEPTH):
        mod = [m[:, None, :] for m in _split(silu_c @ w_mod[l] + b_mod[l], (D_MODEL,) * 6)]
        mod_c = _split(silu_cc @ w_mod[l] + b_mod[l], (D_MODEL,) * 6)
        g = norm_gains[l]
        hy_p = (hy_conv_w[l], hy_conv_b[l], hy_w1[l], hy_b1[l], hy_freq[l], hy_w2[l], hy_b2[l], hy_w3[l], hy_skip[l])
        hc = modulate(rms_norm(xc, g[0]), mod_c[0], mod_c[1])
        kv_c = context_kv(hc, w_in[l])
        h = modulate(rms_norm(x, g[0]), mod[0], mod[1])
        mix = latent_mixers(h, kv_c, w_in[l], hy_p, na_rpb[l], swa_sink[l], w_branch[l], w_out[l], cos, sin)
        x = x + mod[2] * rms_norm(mix, g[1])
        hf = modulate(rms_norm(x, g[2]), mod[3], mod[4])
        x = x + mod[5] * rms_norm(conv_glu(hf, ffn_w_up[l], ffn_conv_w[l], ffn_conv_b[l], ffn_w_down[l]), g[3])
        if l < DEPTH - 1:
            mix_c = context_mixers(hc, kv_c, w_in[l], hy_p, swa_sink[l], w_branch[l], w_out[l])
            xc = xc + mod_c[2] * rms_norm(mix_c, g[1])
            hfc = modulate(rms_norm(xc, g[2]), mod_c[3], mod_c[4])
            xc = xc + mod_c[5] * rms_norm(conv_glu(hfc, ffn_w_up[l], ffn_conv_w[l], ffn_conv_b[l], ffn_w_down[l]), g[3])
    return x
```

```cpp
#include <hip/hip_runtime.h>
#include <cstdio>
#include <cstdint>
#include <cmath>
namespace pg8 {
#define PG8_LAS __attribute__((address_space(3)))
typedef unsigned short bf16_t;
typedef short bf16x8 __attribute__((ext_vector_type(8)));
typedef float f32x4 __attribute__((ext_vector_type(4)));
typedef unsigned u32x4 __attribute__((ext_vector_type(4)));
constexpr int BM = 256, BK = 64, HALF = 128, HTB = HALF * BK * 2  , STAGE_BYTES = 8 * HTB, NXCD = 8, WGM = 8;

__host__ __device__ __forceinline__ int lds_byte(int r, int c) { const int st = (r >> 4) * 2 + (c >> 5), rr = r & 15, cc = c & 31, ob = rr * 64 + cc * 2; return st * 1024 + (ob ^ (((ob >> 9) & 1) << 5)); }
__host__ __device__ __forceinline__ void stage_rc(int b, int& R, int& C) { const int st = b / 1024, sb = b % 1024, swz = sb ^ (((sb >> 9) & 1) << 5); R = (st >> 1) * 16 + swz / 64; C = (st & 1) * 32 + (swz % 64) / 2; }
__host__ __device__ __forceinline__ int perm32(int rho) { const int n = rho >> 4, i = rho & 15; return 8 * (i >> 2) + 4 * n + (i & 3); }

struct Unit { int pm, pn, ks; };
struct Gemm { const bf16_t* A; const bf16_t* Bt; int M, N, K, lda, ldb; };

struct StaticOrder {
    int nM, nN, nwg, G, c;
    __host__ __device__ __forceinline__ void init(int M, int N, int G_, int c_) { nM = M / BM; nN = N / BM; nwg = nM * nN; G = G_; c = c_; }
    __host__ __device__ __forceinline__ bool next(int i, Unit& u) const {
        const long L = (long)i * G + c; if (L >= nwg) return false;
        int wgid = (int)L; { const int q = nwg / NXCD, r = nwg % NXCD, xcd = wgid % NXCD, off = wgid / NXCD; wgid = (xcd < r ? xcd * (q + 1) : r * (q + 1) + (xcd - r) * q) + off; }
        const int nig = WGM * nN, gid = wgid / nig, fm = gid * WGM, gsz = (nM - fm) < WGM ? (nM - fm) : WGM;
        u.pm = fm + ((wgid % nig) % gsz); u.pn = (wgid % nig) / gsz; u.ks = 0; return true;
    }
    __device__ __forceinline__ void a_ready(const Unit&) const {}
    __device__ __forceinline__ void done(const Unit&) const {}
};

struct OneUnit {
    Unit u;
    __host__ __device__ __forceinline__ bool next(int i, Unit& o) const { if (i != 0) return false; o = u; return true; }
    __device__ __forceinline__ void a_ready(const Unit&) const {}
    __device__ __forceinline__ void done(const Unit&) const {}
};
struct SplitOrder {
    int nM, nN, S, nwg, G, c;
    __host__ __device__ __forceinline__ void init(int M, int N, int S_, int G_, int c_) { nM = M / BM; nN = N / BM; S = S_; nwg = nM * nN * S_; G = G_; c = c_; }
    __host__ __device__ __forceinline__ bool next(int i, Unit& u) const { const long L = (long)i * G + c; if (L >= nwg) return false; const int t = (int)L / S; u.ks = (int)L % S; u.pm = t % nM; u.pn = t / nM; return true; }
    __device__ __forceinline__ void a_ready(const Unit&) const {}
    __device__ __forceinline__ void done(const Unit&) const {}
};
__device__ __forceinline__ unsigned cvt_pk_bf16(float lo, float hi) { unsigned r; asm volatile("v_cvt_pk_bf16_f32 %0, %1, %2" : "=v"(r) : "v"(lo), "v"(hi)); return r; }
typedef float f32x2 __attribute__((ext_vector_type(2)));
__device__ __forceinline__ float bf_lo(unsigned u) { return __uint_as_float(u << 16); }
__device__ __forceinline__ float bf_hi(unsigned u) { return __uint_as_float(u & 0xffff0000u); }
__device__ __forceinline__ float sigmoid_f(float x) { return __builtin_amdgcn_rcpf(1.0f + __builtin_amdgcn_exp2f(-1.44269504f * x)); }
struct EpiBf16P {
    static constexpr bool PERM = true, AFTER_DRAIN = false, MIDK = false;
    bf16_t* O; int ldc;
    __device__ __forceinline__ void operator()(const f32x4 (&acc)[2][2][4][2], const Unit& u, int wr, int wc, int fr, int fq) const {
        const int row0 = u.pm * BM + wr * 64 + fr, col0 = u.pn * BM + wc * 32 + 8 * fq;
#pragma unroll
        for (int ai = 0; ai < 2; ++ai)
#pragma unroll
            for (int m = 0; m < 4; ++m) { bf16_t* rowp = O + (size_t)(row0 + ai * HALF + m * 16) * ldc + col0;
#pragma unroll
                for (int bj = 0; bj < 2; ++bj) { const f32x4 v0 = acc[ai][bj][m][0], v1 = acc[ai][bj][m][1];
                    u32x4 w; w.x = cvt_pk_bf16(v0[0], v0[1]); w.y = cvt_pk_bf16(v0[2], v0[3]); w.z = cvt_pk_bf16(v1[0], v1[1]); w.w = cvt_pk_bf16(v1[2], v1[3]);
                    *(u32x4*)(rowp + bj * HALF) = w; } }
    }
};
struct EpiF32P {
    static constexpr bool PERM = false, AFTER_DRAIN = false, MIDK = false;
    float* C; int ldc;
    __device__ __forceinline__ void operator()(const f32x4 (&acc)[2][2][4][2], const Unit& u, int wr, int wc, int fr, int fq) const {
        const int row0 = u.pm * BM + wr * 64 + fr, col0 = u.pn * BM + wc * 32 + 4 * fq;
#pragma unroll
        for (int ai = 0; ai < 2; ++ai)
#pragma unroll
            for (int m = 0; m < 4; ++m) { float* rowp = C + (size_t)(row0 + ai * HALF + m * 16) * ldc + col0;
#pragma unroll
                for (int bj = 0; bj < 2; ++bj)
#pragma unroll
                    for (int n = 0; n < 2; ++n) *(f32x4*)(rowp + bj * HALF + n * 16) = acc[ai][bj][m][n]; }
    }
};
struct EpiBf16Gate {
    static constexpr bool PERM = true, AFTER_DRAIN = false, MIDK = false;
    bf16_t* O; int ldc; int gate_tile0;
    __device__ __forceinline__ void operator()(const f32x4 (&acc)[2][2][4][2], const Unit& u, int wr, int wc, int fr, int fq) const {
        const int row0 = u.pm * BM + wr * 64 + fr, col0 = u.pn * BM + wc * 32 + 8 * fq; const bool gate = u.pn >= gate_tile0;
#pragma unroll
        for (int ai = 0; ai < 2; ++ai)
#pragma unroll
            for (int m = 0; m < 4; ++m) { bf16_t* rowp = O + (size_t)(row0 + ai * HALF + m * 16) * ldc + col0;
#pragma unroll
                for (int bj = 0; bj < 2; ++bj) { f32x4 v0 = acc[ai][bj][m][0], v1 = acc[ai][bj][m][1];
                    if (gate) {
#pragma unroll
                        for (int e = 0; e < 4; ++e) { v0[e] = fmaxf(sigmoid_f(v0[e]), 1e-12f); v1[e] = fmaxf(sigmoid_f(v1[e]), 1e-12f); } }
                    u32x4 w; w.x = cvt_pk_bf16(v0[0], v0[1]); w.y = cvt_pk_bf16(v0[2], v0[3]); w.z = cvt_pk_bf16(v1[0], v1[1]); w.w = cvt_pk_bf16(v1[2], v1[3]);
                    *(u32x4*)(rowp + bj * HALF) = w; } }
    }
};
struct EpiMergeK {
    static constexpr bool PERM = true, AFTER_DRAIN = false, MIDK = true;
    static constexpr int KB0 = 16, KB1 = 24;
    const bf16_t* gate; int ldg;
    bf16_t* O; int ldc;
    __device__ __forceinline__ void midk(f32x4 (&acc)[2][2][4][2], const Unit& u, int b, int wr, int wc, int fr, int fq) const {
        const int row0 = u.pm * BM + wr * 64 + fr, col0 = u.pn * BM + wc * 32 + 8 * fq;
#pragma unroll
        for (int ai = 0; ai < 2; ++ai) {
            u32x4 ga[4][2], gb[4][2];
#pragma unroll
            for (int m = 0; m < 4; ++m)
#pragma unroll
                for (int bj = 0; bj < 2; ++bj) { const bf16_t* gp = gate + (size_t)(row0 + ai * HALF + m * 16) * ldg + b * 2048 + col0 + bj * HALF; ga[m][bj] = *(const u32x4*)gp; gb[m][bj] = *(const u32x4*)(gp + 2048); }
#pragma unroll
            for (int m = 0; m < 4; ++m)
#pragma unroll
                for (int bj = 0; bj < 2; ++bj) { const u32x4 x = ga[m][bj], y = gb[m][bj];
                    acc[ai][bj][m][0][0] *= bf_lo(x.x) * __builtin_amdgcn_rcpf(bf_lo(y.x)); acc[ai][bj][m][0][1] *= bf_hi(x.x) * __builtin_amdgcn_rcpf(bf_hi(y.x));
                    acc[ai][bj][m][0][2] *= bf_lo(x.y) * __builtin_amdgcn_rcpf(bf_lo(y.y)); acc[ai][bj][m][0][3] *= bf_hi(x.y) * __builtin_amdgcn_rcpf(bf_hi(y.y));
                    acc[ai][bj][m][1][0] *= bf_lo(x.z) * __builtin_amdgcn_rcpf(bf_lo(y.z)); acc[ai][bj][m][1][1] *= bf_hi(x.z) * __builtin_amdgcn_rcpf(bf_hi(y.z));
                    acc[ai][bj][m][1][2] *= bf_lo(x.w) * __builtin_amdgcn_rcpf(bf_lo(y.w)); acc[ai][bj][m][1][3] *= bf_hi(x.w) * __builtin_amdgcn_rcpf(bf_hi(y.w)); }
        }
    }
    __device__ __forceinline__ void operator()(const f32x4 (&acc)[2][2][4][2], const Unit& u, int wr, int wc, int fr, int fq) const {
        const int row0 = u.pm * BM + wr * 64 + fr, col0 = u.pn * BM + wc * 32 + 8 * fq;
#pragma unroll
        for (int ai = 0; ai < 2; ++ai)
#pragma unroll
            for (int m = 0; m < 4; ++m) { const size_t row = (size_t)(row0 + ai * HALF + m * 16);
#pragma unroll
                for (int bj = 0; bj < 2; ++bj) { const f32x4 v0 = acc[ai][bj][m][0], v1 = acc[ai][bj][m][1];
                    const u32x4 g = *(const u32x4*)(gate + row * ldg + 2 * 2048 + col0 + bj * HALF);
                    u32x4 w; w.x = cvt_pk_bf16(v0[0] * bf_lo(g.x), v0[1] * bf_hi(g.x)); w.y = cvt_pk_bf16(v0[2] * bf_lo(g.y), v0[3] * bf_hi(g.y));
                    w.z = cvt_pk_bf16(v1[0] * bf_lo(g.z), v1[1] * bf_hi(g.z)); w.w = cvt_pk_bf16(v1[2] * bf_lo(g.w), v1[3] * bf_hi(g.w));
                    *(u32x4*)(O + row * ldc + col0 + bj * HALF) = w; } }
    }
};
typedef _Float16 h4v_t __attribute__((ext_vector_type(4)));
struct EpiF32Slab {
    static constexpr bool PERM = false, AFTER_DRAIN = false, MIDK = false;
    _Float16* C; int ldc; size_t slab;
    __device__ __forceinline__ void operator()(const f32x4 (&acc)[2][2][4][2], const Unit& u, int wr, int wc, int fr, int fq) const {
        const int row0 = u.pm * BM + wr * 64 + fr, col0 = u.pn * BM + wc * 32 + 4 * fq;
        _Float16* base = C + (size_t)u.ks * slab;
#pragma unroll
        for (int ai = 0; ai < 2; ++ai)
#pragma unroll
            for (int m = 0; m < 4; ++m) { _Float16* rowp = base + (size_t)(row0 + ai * HALF + m * 16) * ldc + col0;
#pragma unroll
                for (int bj = 0; bj < 2; ++bj)
#pragma unroll
                    for (int n = 0; n < 2; ++n) { const f32x4 a = acc[ai][bj][m][n]; h4v_t h; h.x = (_Float16)a[0]; h.y = (_Float16)a[1]; h.z = (_Float16)a[2]; h.w = (_Float16)a[3]; *(h4v_t*)(rowp + bj * HALF + n * 16) = h; } }
    }
};
struct EpiAct {
    static constexpr bool PERM = true, AFTER_DRAIN = true, MIDK = false;
    bf16_t* ACT; int dff;
    const float* cw; const float* cb;
    float* HP; float* HU; float* HA;
    __device__ __forceinline__ void refuse(size_t, size_t, int, int) const {}
    __device__ __forceinline__ void fused(f32x4 (&acc)[2][2][4][2], const Unit& u, int wr, int wc, int fr, int fq, PG8_LAS unsigned char* lds, int wid, int lane) const {
        const int cl = wc * 32 + 8 * fq;
        const int j0 = u.pn * 128 + cl;
#pragma unroll
        for (int ai = 0; ai < 2; ++ai)
#pragma unroll
            for (int m = 0; m < 4; ++m) { const int r = ai * HALF + wr * 64 + m * 16 + fr; const f32x4 v0 = acc[ai][0][m][0], v1 = acc[ai][0][m][1];
                u32x4 w; w.x = cvt_pk_bf16(v0[0], v0[1]); w.y = cvt_pk_bf16(v0[2], v0[3]); w.z = cvt_pk_bf16(v1[0], v1[1]); w.w = cvt_pk_bf16(v1[2], v1[3]);
                *(PG8_LAS u32x4*)(lds + r * 272 + cl * 2) = w; }
        float w0[8], w1[8], w2[8], bb[8];
#pragma unroll
        for (int q = 0; q < 2; ++q) { const f32x4 a = *(const f32x4*)(cw + j0 + 4 * q), b = *(const f32x4*)(cw + dff + j0 + 4 * q), c = *(const f32x4*)(cw + 2 * dff + j0 + 4 * q), d = *(const f32x4*)(cb + j0 + 4 * q);
#pragma unroll
            for (int e = 0; e < 4; ++e) { w0[4 * q + e] = a[e]; w1[4 * q + e] = b[e]; w2[4 * q + e] = c[e]; bb[4 * q + e] = d[e]; } }
        asm volatile("s_waitcnt lgkmcnt(0)" ::: "memory"); __builtin_amdgcn_s_barrier(); asm volatile("" ::: "memory");
        const int t0 = u.pm * BM;
        const int seqlen = t0 < 16384 ? 4096 : 256;
        const bool top_open = (t0 % seqlen) != 0, bot_open = ((t0 + BM) % seqlen) != 0;
#pragma unroll
        for (int ai = 0; ai < 2; ++ai)
#pragma unroll
            for (int m = 0; m < 4; ++m) { const int r = ai * HALF + wr * 64 + m * 16 + fr;
                const u32x4 zero = {0u, 0u, 0u, 0u};
                const u32x4 pv = r > 0 ? *(const PG8_LAS u32x4*)(lds + (r - 1) * 272 + cl * 2) : zero;
                const u32x4 nx = r < BM - 1 ? *(const PG8_LAS u32x4*)(lds + (r + 1) * 272 + cl * 2) : zero;
                const f32x4 a0 = acc[ai][0][m][0], a1 = acc[ai][0][m][1], u0 = acc[ai][1][m][0], u1 = acc[ai][1][m][1];
                const float ac[8] = {a0[0], a0[1], a0[2], a0[3], a1[0], a1[1], a1[2], a1[3]}, uc[8] = {u0[0], u0[1], u0[2], u0[3], u1[0], u1[1], u1[2], u1[3]};
                const float pf[8] = {bf_lo(pv.x), bf_hi(pv.x), bf_lo(pv.y), bf_hi(pv.y), bf_lo(pv.z), bf_hi(pv.z), bf_lo(pv.w), bf_hi(pv.w)};
                const float nf[8] = {bf_lo(nx.x), bf_hi(nx.x), bf_lo(nx.y), bf_hi(nx.y), bf_lo(nx.z), bf_hi(nx.z), bf_lo(nx.w), bf_hi(nx.w)};
                float pre[8], res[8];
#pragma unroll
                for (int e = 0; e < 8; ++e) { pre[e] = w0[e] * pf[e] + w1[e] * ac[e] + w2[e] * nf[e] + bb[e]; res[e] = pre[e] * sigmoid_f(pre[e]) * uc[e]; }
                const bool edge0 = (r == 0), edge1 = (r == BM - 1);
                if (edge0 || edge1) {
                    const size_t ho = ((size_t)u.pm * 2 + (edge1 ? 1 : 0)) * dff + j0;
#pragma unroll
                    for (int q = 0; q < 2; ++q) { *(f32x4*)(HA + ho + 4 * q) = (f32x4){ac[4 * q], ac[4 * q + 1], ac[4 * q + 2], ac[4 * q + 3]};
                        *(f32x4*)(HP + ho + 4 * q) = (f32x4){pre[4 * q], pre[4 * q + 1], pre[4 * q + 2], pre[4 * q + 3]}; *(f32x4*)(HU + ho + 4 * q) = (f32x4){uc[4 * q], uc[4 * q + 1], uc[4 * q + 2], uc[4 * q + 3]}; }
                }
                if (!((edge0 && top_open) || (edge1 && bot_open))) {
                    u32x4 w; w.x = cvt_pk_bf16(res[0], res[1]); w.y = cvt_pk_bf16(res[2], res[3]); w.z = cvt_pk_bf16(res[4], res[5]); w.w = cvt_pk_bf16(res[6], res[7]);
                    *(u32x4*)(ACT + (size_t)(t0 + r) * dff + j0) = w; }
            }
    }
};
template <class Epi, class Sched, bool ALIGN_EPI = false, bool SP2 = false>
__device__ __forceinline__ void gemm_phase(PG8_LAS unsigned char* lds, const Gemm g, const Sched& S, const Epi& E, int tid_in) {
    int tid_ = tid_in; asm volatile("" : "+v"(tid_));
    const int tid = tid_, wid = __builtin_amdgcn_readfirstlane(tid >> 6), lane = tid & 63, wr = wid >> 2, wc = wid & 3, fr = lane & 15, fq = lane >> 4;
    const int K = g.K, nt = K / BK;
    unsigned voffA[2], voffB[2];
#pragma unroll
    for (int i = 0; i < 2; ++i) { int R, C; stage_rc(tid * 16 + i * 8192, R, C); const int Rb = Epi::PERM ? ((R & ~31) + perm32(R & 31)) : R;
        voffA[i] = (unsigned)(R * g.lda + C) * 2u; voffB[i] = (unsigned)(Rb * g.ldb + C) * 2u; }
    const size_t kstep = (size_t)(BK * 2);
    const size_t hstepA = (size_t)HALF * g.lda * 2, hstepB = (size_t)HALF * g.ldb * 2;
    const size_t tstepA = 2 * hstepA, tstepB = 2 * hstepB;
    const size_t sstep = (size_t)K * 2;
    const unsigned ldsw = (unsigned)wid * 1024u;
    const int aoff = lds_byte(wr * 64 + fr, fq * 8), boff = lds_byte(wc * 32 + fr, fq * 8);
#define PG8_SA(b, h) (((b) * 2 + (h)) * HTB)
#define PG8_SB(b, h) ((4 + (b) * 2 + (h)) * HTB)
#define PG8_STAGE(bufoff, gbase, voff) do { _Pragma("unroll") for (int _i = 0; _i < 2; ++_i) \
        __builtin_amdgcn_global_load_lds((const unsigned*)((const char*)(gbase) + (voff)[_i]), (PG8_LAS unsigned*)(lds + (bufoff) + ldsw + _i * 8192), 16, 0, 0); } while (0)
#define PG8_LDA(dst, b, h) do { _Pragma("unroll") for (int m = 0; m < 4; ++m) _Pragma("unroll") for (int k = 0; k < 2; ++k) dst[m][k] = *(const PG8_LAS bf16x8*)(lds + PG8_SA(b, h) + aoff + m * 2048 + k * 1024); } while (0)
#define PG8_LDB(dst, b, h) do { _Pragma("unroll") for (int n = 0; n < 2; ++n) _Pragma("unroll") for (int k = 0; k < 2; ++k) dst[n][k] = *(const PG8_LAS bf16x8*)(lds + PG8_SB(b, h) + boff + n * 2048 + k * 1024); } while (0)
#define PG8_MMA(ai, bj, At, Bt) do { __builtin_amdgcn_s_setprio(1); _Pragma("unroll") for (int m = 0; m < 4; ++m) _Pragma("unroll") for (int n = 0; n < 2; ++n) _Pragma("unroll") for (int k = 0; k < 2; ++k) \
        acc[ai][bj][m][n] = __builtin_amdgcn_mfma_f32_16x16x32_bf16(Bt[n][k], At[m][k], acc[ai][bj][m][n], 0, 0, 0); __builtin_amdgcn_s_setprio(0); } while (0)
#define PG8_WAIT_V(n) asm volatile("s_waitcnt vmcnt(" #n ")" ::: "memory")
#define PG8_WAIT_L(n) asm volatile("s_waitcnt lgkmcnt(" #n ")" ::: "memory")
#define PG8_BAR __builtin_amdgcn_s_barrier()
#define PG8_SCHED __builtin_amdgcn_sched_barrier(0)
    Unit cur, nxt; int ui = 0;
    if (!S.next(0, cur)) return;
    f32x4 acc[2][2][4][2];
#pragma unroll
    for (int a = 0; a < 2; ++a)
#pragma unroll
        for (int b = 0; b < 2; ++b)
#pragma unroll
            for (int m = 0; m < 4; ++m)
#pragma unroll
                for (int n = 0; n < 2; ++n) acc[a][b][m][n] = (f32x4){0.f, 0.f, 0.f, 0.f};
    bf16x8 At[4][2], B0[2][2], B1[2][2];
    const char* cA = (const char*)g.A + (size_t)cur.pm * tstepA + (size_t)cur.ks * sstep; const char* cB = (const char*)g.Bt + (size_t)cur.pn * tstepB + (size_t)cur.ks * sstep;
    S.a_ready(cur);
    if constexpr (SP2) {
        PG8_STAGE(PG8_SB(0, 0), cB, voffB); PG8_STAGE(PG8_SB(0, 1), cB + hstepB, voffB); PG8_STAGE(PG8_SA(0, 0), cA, voffA); PG8_STAGE(PG8_SA(0, 1), cA + hstepA, voffA);
        if (wr == 1) PG8_BAR;
        PG8_WAIT_V(2); PG8_BAR;
        PG8_STAGE(PG8_SB(1, 0), cB + kstep, voffB); PG8_STAGE(PG8_SA(1, 0), cA + kstep, voffA); PG8_STAGE(PG8_SB(1, 1), cB + hstepB + kstep, voffB);
        PG8_WAIT_V(6); PG8_BAR;
    } else {
        PG8_STAGE(PG8_SB(0, 0), cB, voffB); PG8_STAGE(PG8_SA(0, 0), cA, voffA); PG8_STAGE(PG8_SB(0, 1), cB + hstepB, voffB); PG8_STAGE(PG8_SA(0, 1), cA + hstepA, voffA);
        if (wr == 1) PG8_BAR;
        PG8_WAIT_V(4); PG8_BAR;
        PG8_STAGE(PG8_SB(1, 0), cB + kstep, voffB); PG8_STAGE(PG8_SA(1, 0), cA + kstep, voffA); PG8_STAGE(PG8_SB(1, 1), cB + hstepB + kstep, voffB);
        PG8_WAIT_V(6); PG8_BAR;
    }
    for (;;) {
        const bool has_next = S.next(ui + 1, nxt);
        const char* nA = has_next ? (const char*)g.A + (size_t)nxt.pm * tstepA + (size_t)nxt.ks * sstep : cA; const char* nB = has_next ? (const char*)g.Bt + (size_t)nxt.pn * tstepB + (size_t)nxt.ks * sstep : cB;
        for (int t = 0; t < nt; t += 2) {
            if constexpr (Epi::MIDK) { if (t == Epi::KB0) E.midk(acc, cur, 0, wr, wc, fr, fq); else if (t == Epi::KB1) E.midk(acc, cur, 1, wr, wc, fr, fq); }
            const bool last = (t == nt - 2);
            const char* a1 = cA + (size_t)(t + 1) * kstep;
            const char* a2 = last ? nA : cA + (size_t)(t + 2) * kstep; const char* b2 = last ? nB : cB + (size_t)(t + 2) * kstep;
            const char* a3 = a2 + kstep; const char* b3 = b2 + kstep;
            if (last && has_next) S.a_ready(nxt);
            if constexpr (SP2) {
            PG8_LDB(B0, 0, 0); PG8_LDB(B1, 0, 1); PG8_SCHED; PG8_LDA(At, 0, 0); PG8_STAGE(PG8_SA(1, 1), a1 + hstepA, voffA);
            PG8_WAIT_V(8); PG8_WAIT_L(0); PG8_BAR; PG8_MMA(0, 0, At, B0); PG8_MMA(0, 1, At, B1); PG8_BAR; PG8_SCHED;
            PG8_LDA(At, 0, 1); PG8_STAGE(PG8_SB(0, 0), b2, voffB); PG8_STAGE(PG8_SB(0, 1), b2 + hstepB, voffB); PG8_STAGE(PG8_SA(0, 0), a2, voffA);
            PG8_WAIT_V(8); PG8_WAIT_L(0); PG8_BAR; PG8_MMA(1, 0, At, B0); PG8_MMA(1, 1, At, B1); PG8_BAR; PG8_SCHED;
            PG8_LDB(B0, 1, 0); PG8_LDB(B1, 1, 1); PG8_SCHED; PG8_LDA(At, 1, 0); PG8_STAGE(PG8_SA(0, 1), a2 + hstepA, voffA);
            PG8_WAIT_V(8); PG8_WAIT_L(0); PG8_BAR; PG8_MMA(0, 0, At, B0); PG8_MMA(0, 1, At, B1); PG8_BAR; PG8_SCHED;
            PG8_LDA(At, 1, 1); PG8_STAGE(PG8_SB(1, 0), b3, voffB); PG8_STAGE(PG8_SB(1, 1), b3 + hstepB, voffB); PG8_STAGE(PG8_SA(1, 0), a3, voffA);
            PG8_WAIT_V(8); PG8_WAIT_L(0); PG8_BAR; PG8_MMA(1, 0, At, B0); PG8_MMA(1, 1, At, B1); PG8_BAR; PG8_SCHED;
            } else {
            PG8_LDB(B0, 0, 0); PG8_SCHED; PG8_LDA(At, 0, 0); PG8_STAGE(PG8_SA(1, 1), a1 + hstepA, voffA);
            PG8_WAIT_L(8); PG8_BAR; PG8_WAIT_L(0); PG8_MMA(0, 0, At, B0); PG8_BAR; PG8_SCHED;
            PG8_LDB(B1, 0, 1); PG8_STAGE(PG8_SB(0, 0), b2, voffB);
            PG8_BAR; PG8_WAIT_L(0); PG8_MMA(0, 1, At, B1); PG8_BAR;
            PG8_LDA(At, 0, 1); PG8_STAGE(PG8_SA(0, 0), a2, voffA);
            PG8_BAR; PG8_WAIT_L(0); PG8_MMA(1, 0, At, B0); PG8_BAR; PG8_SCHED;
            PG8_STAGE(PG8_SB(0, 1), b2 + hstepB, voffB);
            PG8_WAIT_V(6); PG8_BAR; PG8_MMA(1, 1, At, B1); PG8_BAR;
            PG8_LDB(B0, 1, 0); PG8_SCHED; PG8_LDA(At, 1, 0); PG8_STAGE(PG8_SA(0, 1), a2 + hstepA, voffA);
            PG8_WAIT_L(8); PG8_BAR; PG8_WAIT_L(0); PG8_MMA(0, 0, At, B0); PG8_BAR; PG8_SCHED;
            PG8_LDB(B1, 1, 1); PG8_STAGE(PG8_SB(1, 0), b3, voffB);
            PG8_BAR; PG8_WAIT_L(0); PG8_MMA(0, 1, At, B1); PG8_BAR;
            PG8_LDA(At, 1, 1); PG8_STAGE(PG8_SA(1, 0), a3, voffA);
            PG8_BAR; PG8_WAIT_L(0); PG8_MMA(1, 0, At, B0); PG8_BAR; PG8_SCHED;
            PG8_STAGE(PG8_SB(1, 1), b3 + hstepB, voffB);
            PG8_WAIT_V(6); PG8_BAR; PG8_MMA(1, 1, At, B1); PG8_BAR;
            }
        }
        if constexpr (ALIGN_EPI) { if (wr == 0) PG8_BAR; }
        if constexpr (!Epi::AFTER_DRAIN) { E(acc, cur, wr, wc, fr, fq); S.done(cur); }
        if (!has_next) break;
#pragma unroll
        for (int a = 0; a < 2; ++a)
#pragma unroll
            for (int b = 0; b < 2; ++b)
#pragma unroll
                for (int m = 0; m < 4; ++m)
#pragma unroll
                    for (int n = 0; n < 2; ++n) acc[a][b][m][n] = (f32x4){0.f, 0.f, 0.f, 0.f};
        cur = nxt; cA = nA; cB = nB; ++ui;
        if constexpr (ALIGN_EPI) { if (wr == 1) PG8_BAR; }
    }
    PG8_WAIT_V(0);
    if constexpr (!ALIGN_EPI) { if (wr == 0) PG8_BAR; }
    PG8_BAR;
    if constexpr (Epi::AFTER_DRAIN) { E.fused(acc, cur, wr, wc, fr, fq, lds, wid, lane); S.done(cur); }
#undef PG8_SA
#undef PG8_SB
#undef PG8_STAGE
#undef PG8_LDA
#undef PG8_LDB
#undef PG8_MMA
#undef PG8_WAIT_V
#undef PG8_WAIT_L
#undef PG8_BAR
#undef PG8_SCHED
}
}
#define HD __host__ __device__ __forceinline__
#if defined(__HIP_DEVICE_COMPILE__)
#define FFT_PIN() __builtin_amdgcn_sched_barrier(0)
#else
#define FFT_PIN() ((void)0)
#endif
typedef float cf2 __attribute__((ext_vector_type(2)));
HD cf2 cmul(cf2 a, cf2 b) { const cf2 b2 = {-b.y, b.x}; return a.xx * b + a.yy * b2; }
HD constexpr int PADI(int i) { return i + (i >> 5); }
constexpr int FFT_N = 8192, FFT_PADN = 8448;
HD constexpr float c32tab(int k) {
    constexpr float t[16] = {1.0f, 0.98078528040323043f, 0.92387953251128674f, 0.83146961230254524f, 0.70710678118654752f, 0.55557023301960218f, 0.38268343236508977f, 0.19509032201612825f,
                             0.0f, -0.19509032201612825f, -0.38268343236508977f, -0.55557023301960218f, -0.70710678118654752f, -0.83146961230254524f, -0.92387953251128674f, -0.98078528040323043f};
    return t[k];
}
HD constexpr float s32tab(int k) {
    constexpr float t[16] = {0.0f, 0.19509032201612825f, 0.38268343236508977f, 0.55557023301960218f, 0.70710678118654752f, 0.83146961230254524f, 0.92387953251128674f, 0.98078528040323043f,
                             1.0f, 0.98078528040323043f, 0.92387953251128674f, 0.83146961230254524f, 0.70710678118654752f, 0.55557023301960218f, 0.38268343236508977f, 0.19509032201612825f};
    return t[k];
}
HD constexpr int bitrev_c(int x, int bits) { int r = 0; for (int b = 0; b < bits; ++b) r |= ((x >> b) & 1) << (bits - 1 - b); return r; }
template <int R, int LOGR, int SIGN> HD void dft_reg(cf2 (&v)[R]) {
#pragma unroll
    for (int ls = LOGR - 1; ls >= 0; --ls) {
        const int span = 1 << ls;
#pragma unroll
        for (int i = 0; i < R; ++i) {
            if ((i & span) == 0) {
                const int k32 = (i & (span - 1)) * (R / (2 * span)) * (32 / R);
                const cf2 a = v[i], b = v[i + span]; v[i] = a + b; const cf2 d = a - b;
                if (k32 == 0) v[i + span] = d;
                else if (k32 == 8) { const cf2 m = {-(float)SIGN, (float)SIGN}; v[i + span] = d.yx * m; }
                else { const cf2 w1 = {c32tab(k32), (float)SIGN * s32tab(k32)}, w2 = {-(float)SIGN * s32tab(k32), c32tab(k32)}; v[i + span] = d.xx * w1 + d.yy * w2; }
            }
        }
    }
}
template <int R, int LOGR, int PM, bool TW> HD void fft_fwd_group(cf2* Xp, cf2 w) {
    cf2 v[R];
#pragma unroll
    for (int q = 0; q < R; ++q) v[q] = Xp[PM * q];
    dft_reg<R, LOGR, -1>(v);
    cf2 wp = {1.f, 0.f};
#pragma unroll
    for (int q = 0; q < R; ++q) { cf2 y = v[bitrev_c(q, LOGR)];
        if (TW && q > 0) { wp = cmul(wp, w); y = cmul(y, wp); }
        Xp[PM * q] = y; }
}
template <int R, int LOGR, int PM, bool TW> HD void fft_inv_group(cf2* Xp, cf2 w) {
    cf2 v[R];
    const cf2 wc = {w.x, -w.y}; cf2 wp = {1.f, 0.f};
#pragma unroll
    for (int q = 0; q < R; ++q) v[q] = Xp[PM * q];
    FFT_PIN();
#pragma unroll
    for (int q = 1; q < R; ++q) if (TW) { wp = cmul(wp, wc); v[q] = cmul(v[q], wp); }
    dft_reg<R, LOGR, +1>(v);
#pragma unroll
    for (int q = 0; q < R; ++q) Xp[PM * q] = v[bitrev_c(q, LOGR)];
}
HD int fft_pos_to_k(int p) { return (p >> 9) + 16 * ((p >> 5) & 15) + 256 * (p & 31); }
HD int fft_k_to_pos(int k) { return 512 * (k & 15) + 32 * ((k >> 4) & 15) + (k >> 8); }
HD int fft_conj_pos(int p) { return fft_k_to_pos((FFT_N - fft_pos_to_k(p)) & (FFT_N - 1)); }
HD void fft_fwd_passA(cf2* X, const cf2* TWL, int tid) { fft_fwd_group<16, 4, 528, true>(X + PADI(tid), TWL[tid]); }
HD void fft_fwd_passB(cf2* X, const cf2* TWL, int tid) { const int blk = tid >> 5, j = tid & 31; fft_fwd_group<16, 4, 33, true>(X + 528 * blk + j, TWL[16 * j]); }
HD void fft_fwd_passC(cf2* X, int g) { const cf2 w = {1.f, 0.f}; fft_fwd_group<32, 5, 1, false>(X + 33 * g, w); }
HD void fft_inv_passC(cf2* X, int g) { const cf2 w = {1.f, 0.f}; fft_inv_group<32, 5, 1, false>(X + 33 * g, w); }
HD void fft_inv_passB(cf2* X, const cf2* TWL, int tid) { const int blk = tid >> 5, j = tid & 31; fft_inv_group<16, 4, 33, true>(X + 528 * blk + j, TWL[16 * j]); }
HD void fft_inv_passA(cf2* X, const cf2* TWL, int tid) { fft_inv_group<16, 4, 528, true>(X + PADI(tid), TWL[tid]); }
template <class KP> HD void fft_passC_conv_half(cf2* X, const cf2 (&kk)[16], KP K, int g) {
    cf2* Xp = X + 33 * g; cf2 v[32], w[32];
#pragma unroll
    for (int q = 0; q < 32; ++q) v[q] = Xp[q];
    dft_reg<32, 5, -1>(v);
#pragma unroll
    for (int q = 0; q < 16; ++q) w[q] = cmul(v[bitrev_c(q, 5)], kk[q]);
#pragma unroll
    for (int q = 16; q < 32; ++q) { const cf2 k = {K[32 * g + q].x, K[32 * g + q].y}; w[q] = cmul(v[bitrev_c(q, 5)], k); }
    dft_reg<32, 5, +1>(w);
#pragma unroll
    for (int q = 0; q < 32; ++q) Xp[q] = w[bitrev_c(q, 5)];
}
HD void fft_passC_conv_regs(cf2* X, const cf2 (&kk)[32], int g) {
    cf2* Xp = X + 33 * g; cf2 v[32], w[32];
#pragma unroll
    for (int q = 0; q < 32; ++q) v[q] = Xp[q];
    dft_reg<32, 5, -1>(v);
#pragma unroll
    for (int q = 0; q < 32; ++q) w[q] = cmul(v[bitrev_c(q, 5)], kk[q]);
    dft_reg<32, 5, +1>(w);
#pragma unroll
    for (int q = 0; q < 32; ++q) Xp[q] = w[bitrev_c(q, 5)];
}
template <class KP> HD void fft_passC_conv(cf2* X, KP K, int g) {
    cf2* Xp = X + 33 * g; cf2 v[32], w[32];
#pragma unroll
    for (int q = 0; q < 32; ++q) v[q] = Xp[q];
    dft_reg<32, 5, -1>(v);
#pragma unroll
    for (int q = 0; q < 32; ++q) { const cf2 k = {K[32 * g + q].x, K[32 * g + q].y}; w[q] = cmul(v[bitrev_c(q, 5)], k); }
    dft_reg<32, 5, +1>(w);
#pragma unroll
    for (int q = 0; q < 32; ++q) Xp[q] = w[bitrev_c(q, 5)];
}
HD void fft_fwd_passA_zp(cf2* X, const cf2* TWL, int tid) {
    cf2* Xp = X + PADI(tid); cf2 v[16];
#pragma unroll
    for (int q = 0; q < 8; ++q) v[q] = Xp[528 * q];
#pragma unroll
    for (int q = 8; q < 16; ++q) { v[q].x = 0.f; v[q].y = 0.f; }
    dft_reg<16, 4, -1>(v);
    const cf2 w = TWL[tid]; cf2 wp = {1.f, 0.f};
#pragma unroll
    for (int q = 0; q < 16; ++q) { cf2 y = v[bitrev_c(q, 4)]; if (q > 0) { wp = cmul(wp, w); y = cmul(y, wp); } Xp[528 * q] = y; }
}
HD void fft_inv_passA_half(cf2* X, const cf2* TWL, int tid) {
    cf2* Xp = X + PADI(tid); cf2 v[16];
    const cf2 w = TWL[tid]; const cf2 wc = {w.x, -w.y}; cf2 wp = {1.f, 0.f};
#pragma unroll
    for (int q = 0; q < 16; ++q) v[q] = Xp[528 * q];
    FFT_PIN();
#pragma unroll
    for (int q = 1; q < 16; ++q) { wp = cmul(wp, wc); v[q] = cmul(v[q], wp); }
    dft_reg<16, 4, +1>(v);
#pragma unroll
    for (int q = 0; q < 8; ++q) Xp[528 * q] = v[bitrev_c(q, 4)];
}

template <int R, int LOGR, int PM, bool TW, int NLOAD> HD void fft_fwd_group2(cf2* Xp0, cf2* Xp1, cf2 w) {
    cf2 a[R], b[R];
#pragma unroll
    for (int q = 0; q < R; ++q) { if (q < NLOAD) { a[q] = Xp0[PM * q]; b[q] = Xp1[PM * q]; } else { a[q].x = 0.f; a[q].y = 0.f; b[q].x = 0.f; b[q].y = 0.f; } }
    FFT_PIN();
    dft_reg<R, LOGR, -1>(a); dft_reg<R, LOGR, -1>(b);
    cf2 wp = {1.f, 0.f};
#pragma unroll
    for (int q = 0; q < R; ++q) { cf2 ya = a[bitrev_c(q, LOGR)], yb = b[bitrev_c(q, LOGR)];
        if (TW && q > 0) { wp = cmul(wp, w); ya = cmul(ya, wp); yb = cmul(yb, wp); }
        Xp0[PM * q] = ya; Xp1[PM * q] = yb; }
}
template <int R, int LOGR, int PM, bool TW, int NSTORE> HD void fft_inv_group2(cf2* Xp0, cf2* Xp1, cf2 w) {
    cf2 a[R], b[R];
#pragma unroll
    for (int q = 0; q < R; ++q) { a[q] = Xp0[PM * q]; b[q] = Xp1[PM * q]; }
    FFT_PIN();
    const cf2 wc = {w.x, -w.y}; cf2 wp = {1.f, 0.f};
#pragma unroll
    for (int q = 1; q < R; ++q) if (TW) { wp = cmul(wp, wc); a[q] = cmul(a[q], wp); b[q] = cmul(b[q], wp); }
    dft_reg<R, LOGR, +1>(a); dft_reg<R, LOGR, +1>(b);
#pragma unroll
    for (int q = 0; q < NSTORE; ++q) { Xp0[PM * q] = a[bitrev_c(q, LOGR)]; Xp1[PM * q] = b[bitrev_c(q, LOGR)]; }
}
HD void fft_fwd_passA2(cf2* X0, cf2* X1, const cf2* TWL, int tid) { fft_fwd_group2<16, 4, 528, true, 16>(X0 + PADI(tid), X1 + PADI(tid), TWL[tid]); }
HD void fft_fwd_passA2_zp(cf2* X0, cf2* X1, const cf2* TWL, int tid) { fft_fwd_group2<16, 4, 528, true, 8>(X0 + PADI(tid), X1 + PADI(tid), TWL[tid]); }
HD void fft_fwd_passB2(cf2* X0, cf2* X1, const cf2* TWL, int tid) { const int blk = tid >> 5, j = tid & 31; fft_fwd_group2<16, 4, 33, true, 16>(X0 + 528 * blk + j, X1 + 528 * blk + j, TWL[16 * j]); }
HD void fft_inv_passB2(cf2* X0, cf2* X1, const cf2* TWL, int tid) { const int blk = tid >> 5, j = tid & 31; fft_inv_group2<16, 4, 33, true, 16>(X0 + 528 * blk + j, X1 + 528 * blk + j, TWL[16 * j]); }
HD void fft_inv_passA2(cf2* X0, cf2* X1, const cf2* TWL, int tid) { fft_inv_group2<16, 4, 528, true, 16>(X0 + PADI(tid), X1 + PADI(tid), TWL[tid]); }
HD void fft_inv_passA2_half(cf2* X0, cf2* X1, const cf2* TWL, int tid) { fft_inv_group2<16, 4, 528, true, 8>(X0 + PADI(tid), X1 + PADI(tid), TWL[tid]); }
constexpr int DM = 2048, NBATCH = 4, SEQ = 4096, DEPTH = 4, CTXL = 256, HDIM = 128;
constexpr int ML = NBATCH * SEQ, MC = NBATCH * CTXL, MT = ML + MC;
constexpr int HYW = 1024, NIN = 11776, DFF = 5632, NMOD = 6 * DM;
constexpr int NP = 7936, NU = 3840;
constexpr int P_NAK = 0, P_SWK = 512, P_NAQ = 768, P_SWQ = 1280, P_GATE = 1792;
constexpr int U_HY = 0, U_NAV = 3072, U_SWV = 3584;
constexpr float NORM_EPS = 1e-6f;
constexpr float HY_MIN_DECAY = -3.0701134573253945f, HY_MAX_DECAY = -15.350567286626973f;
constexpr int NWAVES = 8, NTHR = 512;

constexpr size_t MiB = 1u << 20;
constexpr size_t WS_CTL = 0, CTL_ZERO_BYTES = 64 * 1024;
constexpr size_t WS_MODV = 1 * MiB;
constexpr size_t WS_ROPE = 2 * MiB;
constexpr size_t WS_MODC = 2 * MiB + 64 * 1024;
constexpr size_t WS_A2 = 3 * MiB;
constexpr size_t WS_A2C = 7 * MiB;
constexpr size_t WS_KC = 8 * MiB, KC_BUF = 4 * MiB;
constexpr size_t WS_XC = 16 * MiB;
constexpr size_t WS_KSPEC = 24 * MiB, KSPEC_BUF = 64 * MiB;
constexpr size_t WS_WSET = 280 * MiB, WSET_BYTES = 128 * MiB;
constexpr size_t WO_WIN = 0, WO_WBR = 46 * MiB, WO_WOUT = 54 * MiB, WO_WUP = 62 * MiB, WO_WDN = 106 * MiB;
constexpr size_t WS_H = 536 * MiB;
constexpr size_t WS_MM = WS_H;
constexpr size_t WS_MIX = 604 * MiB;
constexpr size_t WS_Y = WS_MIX; constexpr int Y_NA = 1024, Y_SW = 1536;
constexpr size_t WS_ACT = 740 * MiB;
constexpr size_t WS_T1 = WS_ACT, WS_T2 = WS_ACT + 68 * MiB;
constexpr size_t WS_P = 927 * MiB;
constexpr size_t WS_UT = 1191 * MiB;
constexpr size_t WS_AU = WS_P;
constexpr size_t WS_HALO = 1319 * MiB, HALO_ONE = 4 * MiB;
constexpr size_t WS_XH = 152 * MiB;
constexpr size_t WS_END = 1331 * MiB;
static_assert(WS_P + (size_t)MT * NP * 2 <= WS_UT && WS_UT + (size_t)NU * MT * 2 <= WS_HALO && (size_t)68 * 2 * DFF * 4 <= HALO_ONE, "ws map");
static_assert(WS_KSPEC + 2 * KSPEC_BUF <= WS_XH && WS_XH + (size_t)MT * DM * 2 <= WS_WSET, "ws map 4");
static_assert(WS_ACT + (size_t)MT * DFF * 2 <= WS_P && WS_MIX + (size_t)MT * DM * 4 <= WS_ACT && WS_H + (size_t)MT * DM * 2 <= WS_MIX && WS_WSET + 2 * WSET_BYTES <= WS_H && WS_KSPEC + 2 * KSPEC_BUF <= WS_WSET, "ws map 2");
static_assert(WO_WDN + (size_t)DM * DFF * 2 <= WSET_BYTES && WS_Y + (size_t)MT * DM * 2 <= WS_MIX + (size_t)MT * DM * 4 && WS_T2 + (size_t)MT * DM * 2 <= WS_ACT + (size_t)MT * DFF * 2, "ws map 3");
constexpr int CW_TMO = 0, CW_CODE = 1, CW_BAR = 4096;

constexpr int LDS_BYTES = 147456;
constexpr int MISC_OFF = 143360;
constexpr int FFT_BUF_BYTES = FFT_PADN * 8;
constexpr int LDS_X0 = 0, LDS_X1 = FFT_BUF_BYTES, LDS_TW = 2 * FFT_BUF_BYTES;
constexpr int LDS_SM = LDS_TW + 4096;
static_assert(LDS_SM + 4096 <= MISC_OFF, "LDS map");

#define GAS __attribute__((address_space(1)))
#define LAS __attribute__((address_space(3)))
typedef unsigned short bf16;
typedef unsigned v4u __attribute__((ext_vector_type(4)));
typedef unsigned v2u __attribute__((ext_vector_type(2)));
typedef float f32x4 __attribute__((ext_vector_type(4)));
typedef float f32x2v __attribute__((ext_vector_type(2)));
typedef short bf16x8 __attribute__((ext_vector_type(8)));
typedef GAS unsigned gu32;
#define RLX_AGENT __ATOMIC_RELAXED, __HIP_MEMORY_SCOPE_AGENT
#define LDS_WAIT() asm volatile("s_waitcnt lgkmcnt(0)" ::: "memory")
#define VM_WAIT() asm volatile("s_waitcnt vmcnt(0)" ::: "memory")
__device__ __forceinline__ unsigned f2bf(float f) { unsigned u = __builtin_bit_cast(unsigned, f); return (u + 0x7fffu + ((u >> 16) & 1u)) >> 16; }
__device__ __forceinline__ unsigned pk2(float lo, float hi) { return pg8::cvt_pk_bf16(lo, hi); }
__device__ __forceinline__ float bf2f(bf16 b) { return __uint_as_float(((unsigned)b) << 16); }
__device__ __forceinline__ float blo(unsigned u) { return __uint_as_float(u << 16); }
__device__ __forceinline__ float bhi(unsigned u) { return __uint_as_float(u & 0xffff0000u); }
__device__ __forceinline__ float wave_sum(float v) {
#define WS_DPP(x, ctrl, rmask) __builtin_bit_cast(float, __builtin_amdgcn_update_dpp(0, __builtin_bit_cast(int, (x)), (ctrl), (rmask), 0xf, false))
    v += WS_DPP(v, 0xB1, 0xf);
    v += WS_DPP(v, 0x4E, 0xf);
    v += WS_DPP(v, 0x141, 0xf);
    v += WS_DPP(v, 0x140, 0xf);
    v += WS_DPP(v, 0x142, 0xa);
    v += WS_DPP(v, 0x143, 0xc);
#undef WS_DPP
    return __builtin_bit_cast(float, __builtin_amdgcn_readlane(__builtin_bit_cast(int, v), 63));
}
#define XB_TMO      128
#define XB_XCNT(j)  (256  + 64 * (j))
#define XB_XSUB(j)  (1280 + 64 * (j))
#define XB_XGEN(j)  (2304 + 64 * (j))
#define XB_TOP      3328
#define XB_TOPGEN   3392
#define XCD_BAR_WORDS 3456
#define XB_SPIN_CAP (1u << 18)

__device__ __forceinline__ unsigned xb_ld(unsigned* p)              { return __hip_atomic_load(p, __ATOMIC_RELAXED, __HIP_MEMORY_SCOPE_AGENT); }
__device__ __forceinline__ unsigned xb_add(unsigned* p, unsigned v) { return __hip_atomic_fetch_add(p, v, __ATOMIC_RELAXED, __HIP_MEMORY_SCOPE_AGENT); }
__device__ __forceinline__ unsigned xb_xcc_id() { return (unsigned)__builtin_amdgcn_s_getreg((3 << 11) | 20) & 0xFu; }
#define XB_SPIN(cond, bar) do { unsigned _sp = 0; while (cond) { __builtin_amdgcn_s_sleep(1); \
    if ((++_sp & 255u) == 0u) { if (xb_ld(&(bar)[XB_TMO])) break; if (_sp > XB_SPIN_CAP) { atomicAdd(&(bar)[XB_TMO], 1u); break; } } } } while (0)

struct XcdBarrier {
    unsigned* bar; unsigned x;
    volatile LAS unsigned* st;
};

__device__ __forceinline__ XcdBarrier xcd_barrier_post(unsigned* bar, volatile LAS unsigned* st, int tid) {
    XcdBarrier b; b.bar = bar; b.x = xb_xcc_id(); b.st = st;
    if (tid == 0) (void)xb_add(&bar[XB_XCNT(b.x)], 1u);
    return b;
}
__device__ __forceinline__ void xcd_barrier_complete(unsigned* bar, unsigned x, unsigned& nloc, unsigned& nx) {
    const unsigned G = gridDim.x * gridDim.y * gridDim.z;
    unsigned sum, cnt, mine, sp = 0u;
    for (;;) {
        sum = 0u; cnt = 0u; mine = 0u;
#pragma unroll 1
        for (unsigned j = 0; j < 16; ++j) { const unsigned c = xb_ld(&bar[XB_XCNT(j)]); sum += c; cnt += (c > 0u) ? 1u : 0u; mine = (j == x) ? c : mine; }
        if (sum == G) break;
        __builtin_amdgcn_s_sleep(1);
        if ((++sp & 255u) == 0u) { if (xb_ld(&bar[XB_TMO])) break; if (sp > XB_SPIN_CAP) { atomicAdd(&bar[XB_TMO], 1u); break; } }
    }
    nloc = mine > 0u ? mine : 1u; nx = cnt > 0u ? cnt : 1u;
}

__device__ __forceinline__ void xcd_barrier(const XcdBarrier& b, int tid) {
    asm volatile("s_waitcnt vmcnt(0)" ::: "memory");
    __syncthreads();
    if (tid == 0) {
        unsigned* bar = b.bar;
        __builtin_amdgcn_s_waitcnt(0);
        unsigned nloc = b.st[0], nx = b.st[1];
        if (nloc == 0u) { xcd_barrier_complete(bar, b.x, nloc, nx); b.st[0] = nloc; b.st[1] = nx; }
        const unsigned old = xb_add(&bar[XB_XSUB(b.x)], 1u);
        const unsigned gen = old / nloc;
        if (old + 1u == (gen + 1u) * nloc) {
            __builtin_amdgcn_fence(__ATOMIC_RELEASE, "agent");
            asm volatile("s_waitcnt vmcnt(0)" ::: "memory");
            const unsigned og = xb_add(&bar[XB_TOP], 1u);
            const unsigned tg = og / nx;
            if (og + 1u == (tg + 1u) * nx) xb_add(&bar[XB_TOPGEN], 1u);
            else XB_SPIN(xb_ld(&bar[XB_TOPGEN]) == tg, bar);
            __builtin_amdgcn_fence(__ATOMIC_ACQUIRE, "agent");
            xb_add(&bar[XB_XGEN(b.x)], 1u);
            asm volatile("s_waitcnt vmcnt(0)" ::: "memory");
        } else {
            XB_SPIN(xb_ld(&bar[XB_XGEN(b.x)]) == gen, bar);
            __builtin_amdgcn_fence(__ATOMIC_ACQUIRE, "agent");
            asm volatile("s_waitcnt vmcnt(0)" ::: "memory");
        }
    }
    __syncthreads();
}
struct Frame {
    LAS unsigned char* lds;
    unsigned char* ldsg;
    volatile LAS unsigned* MISC;
    gu32* ctl;
    int tid, lane, wave, G, bid;
    unsigned char* ws;
    unsigned long long karg;
};
typedef const float* cfp_t;
__device__ __forceinline__ const float* INP(const Frame& F, int i) { const cfp_t p = ((const __attribute__((address_space(4))) cfp_t*)F.karg)[i]; return (const float*)(const GAS float*)p; }
__device__ __forceinline__ float* OUTP(const Frame& F) { const cfp_t p = ((const __attribute__((address_space(4))) cfp_t*)F.karg)[25]; return (float*)(GAS float*)p; }
enum InIdx { I_X = 0, I_C, I_CTX, I_CCTX, I_WMOD, I_BMOD, I_GAINS, I_WIN, I_HCW, I_HCB, I_HW1, I_HB1, I_HFREQ, I_HW2, I_HB2, I_HW3, I_HSKIP, I_RPB, I_SINK, I_WBR, I_WOUT, I_WUP, I_FCW, I_FCB, I_WDN };

typedef _Float16 h2v __attribute__((ext_vector_type(2)));
typedef _Float16 h4v __attribute__((ext_vector_type(4)));
typedef _Float16 h8v __attribute__((ext_vector_type(8)));
__device__ __forceinline__ unsigned pack_h2(float a, float b) { h2v h; h.x = (_Float16)a; h.y = (_Float16)b; return __builtin_bit_cast(unsigned, h); }
__device__ __forceinline__ void p0_modvec(Frame& F) {
    LAS float* sc = (LAS float*)(F.lds);
    LAS float* part = (LAS float*)(F.lds + 40960);
    float* modv = (float*)(F.ws + WS_MODV);
    if (F.bid < 192) {
        for (int i = F.tid; i < 5 * DM; i += NTHR) { const int r = i >> 11, k = i & 2047; const float x = r < 4 ? INP(F, I_C)[r * DM + k] : INP(F, I_CCTX)[k]; sc[i] = x / (1.0f + expf(-x)); }
        __syncthreads();
        for (int it = F.bid; it < 192; it += F.G) {
            const int l = it / 48, cg = it % 48;
            const float* W = INP(F, I_WMOD) + (size_t)l * DM * NMOD + cg * 256 + 4 * F.lane;
            float acc[5][4];
#pragma unroll
            for (int r = 0; r < 5; ++r)
#pragma unroll
                for (int j = 0; j < 4; ++j) acc[r][j] = 0.f;
#pragma unroll 8
            for (int i = 0; i < 256; ++i) { const int k = F.wave + 8 * i; const f32x4 w = __builtin_nontemporal_load((const f32x4*)(W + (size_t)k * NMOD));
#pragma unroll
                for (int r = 0; r < 5; ++r) { const float s = sc[r * DM + k];
#pragma unroll
                    for (int j = 0; j < 4; ++j) acc[r][j] += s * w[j]; } }
#pragma unroll
            for (int r = 0; r < 5; ++r)
#pragma unroll
                for (int j = 0; j < 4; ++j) part[(F.wave * 5 + r) * 256 + 4 * F.lane + j] = acc[r][j];
            __syncthreads();
            for (int o = F.tid; o < 1280; o += NTHR) { const int r = o >> 8, cc = o & 255; float s = 0.f;
#pragma unroll
                for (int w = 0; w < 8; ++w) s += part[(w * 5 + r) * 256 + cc];
                const int col = cg * 256 + cc; modv[(size_t)(l * 5 + r) * NMOD + col] = s + INP(F, I_BMOD)[l * NMOD + col]; }
            __syncthreads();
        }
    }
    if (F.bid == F.G - 1) {
        float2* rope = (float2*)(F.ws + WS_ROPE);
        for (int e = F.tid; e < 2048; e += NTHR) { const int pos = e >> 5, i = e & 31; const float inv = powf(10000.0f, -(float)(2 * i) / 64.0f); const float ang = (float)pos * inv; float s, c; sincosf(ang, &s, &c); rope[e] = make_float2(c, s); }
    }
}

__device__ __forceinline__ void load_row(const float* p, int lane, f32x4 (&v)[8]) {
#pragma unroll
    for (int j = 0; j < 8; ++j) v[j] = *(const f32x4*)(p + 4 * lane + 256 * j);
}
__device__ __forceinline__ float row_rstd(const f32x4 (&v)[8]) {
    float s = 0.f;
#pragma unroll
    for (int j = 0; j < 8; ++j) s += (v[j].x * v[j].x + v[j].y * v[j].y) + (v[j].z * v[j].z + v[j].w * v[j].w);
    s = wave_sum(s);
    return 1.0f / sqrtf(s * (1.0f / DM) + NORM_EPS);
}
__device__ __forceinline__ void store_h(bf16* hrow, int lane, const f32x4 (&x)[8], float rstd, const float* g, const float* shift, const float* scale) {
#pragma unroll
    for (int j = 0; j < 8; ++j) { const int col = 4 * lane + 256 * j;
        const f32x4 gg = *(const f32x4*)(g + col), sh = *(const f32x4*)(shift + col), sc = *(const f32x4*)(scale + col);
        const f32x4 y = (x[j] * rstd * gg) * (1.0f + sc) + sh;
        v2u o; o.x = pk2(y.x, y.y); o.y = pk2(y.z, y.w); *(v2u*)(hrow + col) = o; }
}
__device__ __forceinline__ int row_bidx(int m) { return m < ML ? (m >> 12) : 4; }
__device__ __forceinline__ float* xrow_ptr(Frame& F, int m) { return m < ML ? OUTP(F) + (size_t)m * DM : (float*)(F.ws + WS_XC) + (size_t)(m - ML) * DM; }
__device__ __forceinline__ const float* xin_ptr(Frame& F, int m) { return m < ML ? INP(F, I_X) + (size_t)m * DM : INP(F, I_CTX) + (size_t)(m - ML) * DM; }
__device__ __forceinline__ void rows_first(Frame& F) {
    const int gw = F.bid * NWAVES + F.wave, NGW = F.G * NWAVES;
    const float* modv = (const float*)(F.ws + WS_MODV); bf16* H = (bf16*)(F.ws + WS_H);
    for (int m = gw; m < MT; m += NGW) {
        f32x4 x[8]; load_row(xin_ptr(F, m), F.lane, x);
        const float rstd = row_rstd(x);
        const float* mv = modv + (size_t)(0 * 5 + row_bidx(m)) * NMOD;
        store_h(H + (size_t)m * DM, F.lane, x, rstd, INP(F, I_GAINS) + 0, mv + 0 * DM, mv + 1 * DM);
    }
}
__device__ __forceinline__ void p1_modcomb(Frame& F) {
    const float* modv = (const float*)(F.ws + WS_MODV); _Float16* mc = (_Float16*)(F.ws + WS_MODC); const float* gains = INP(F, I_GAINS);
    for (int i = F.bid * NTHR + F.tid; i < DEPTH * 5 * DM; i += F.G * NTHR) { const int lb = i >> 11, col = i & 2047, l = lb / 5;
        const float* mv = modv + (size_t)lb * NMOD + col; const float* g = gains + (size_t)l * 4 * DM + col; _Float16* o = mc + (size_t)lb * 6 * DM + col;
        o[0] = (_Float16)(mv[2 * DM] * g[1 * DM]); o[DM] = (_Float16)(g[2 * DM] * (1.0f + mv[4 * DM])); o[2 * DM] = (_Float16)mv[3 * DM];
        o[3 * DM] = (_Float16)(mv[5 * DM] * g[3 * DM]); o[4 * DM] = (_Float16)(g[0] * (1.0f + mv[1 * DM])); o[5 * DM] = (_Float16)mv[0]; }
}
__device__ __forceinline__ f32x4 ldh4(const _Float16* p) { const h4v h = *(const h4v*)p; return (f32x4){(float)h.x, (float)h.y, (float)h.z, (float)h.w}; }
__device__ __forceinline__ void load_row_h(const unsigned* p, int lane, f32x4 (&v)[8]) {
#pragma unroll
    for (int j = 0; j < 8; ++j) { const h4v h = *(const h4v*)(p + 2 * lane + 128 * j); v[j] = (f32x4){(float)h.x, (float)h.y, (float)h.z, (float)h.w}; }
}
__device__ __forceinline__ float clamp_h(float x) { return __builtin_amdgcn_fmed3f(x, -65000.0f, 65000.0f); }
__device__ __forceinline__ void rows_residual(Frame& F, int l, const float* SRC, int which, int mrows, bool x_from_input, bool x_to_output) {
    const int gw = F.bid * NWAVES + F.wave, NGW = F.G * NWAVES;
    const _Float16* mc = (const _Float16*)(F.ws + WS_MODC); bf16* H = (bf16*)(F.ws + WS_H);
    const bool has_h = (which == 0) || (l + 1 < DEPTH); const int lh = which == 0 ? l : l + 1;
    LAS float* lv = (LAS float*)F.lds;
    __syncthreads();
    for (int i = F.tid; i < 5 * 3 * (DM / 4); i += NTHR) { const int v = i / (DM / 4), c4 = i % (DM / 4), bi = v / 3, k = v % 3;
        const _Float16* src = (k == 0) ? mc + (size_t)((l * 5 + bi) * 6 + (which == 0 ? 0 : 3)) * DM : mc + (size_t)((lh * 5 + bi) * 6 + (which == 0 ? 1 : 4) + (k - 1)) * DM;
        h4v t = {(_Float16)0.f, (_Float16)0.f, (_Float16)0.f, (_Float16)0.f}; if (k == 0 || has_h) t = *(const h4v*)(src + 4 * c4);
        *(LAS f32x4*)(lv + (size_t)v * DM + 4 * c4) = (f32x4){(float)t.x, (float)t.y, (float)t.z, (float)t.w}; }
    __syncthreads();
    for (int m = gw; m < mrows; m += NGW) {
        const int bi = row_bidx(m);
        const LAS float* Ap = lv + (bi * 3) * DM + 4 * F.lane;
        f32x4 A[8];
#pragma unroll
        for (int j = 0; j < 8; ++j) A[j] = *(const LAS f32x4*)(Ap + 256 * j);
        f32x4 s[8];
        if (m < ML) { const bf16* sb = (const bf16*)SRC + (size_t)m * DM;
#pragma unroll
            for (int j = 0; j < 8; ++j) { const v2u r = *(const v2u*)(sb + 4 * F.lane + 256 * j); s[j] = (f32x4){blo(r.x), bhi(r.x), blo(r.y), bhi(r.y)}; } }
        else {
            const unsigned* sl = (const unsigned*)(F.ws + WS_UT) + (size_t)(m - ML) * (DM / 2); load_row_h(sl, F.lane, s);
            for (int k = 1; k < 4; ++k) { f32x4 t[8]; load_row_h(sl + (size_t)k * MC * (DM / 2), F.lane, t);
#pragma unroll
                for (int j = 0; j < 8; ++j) s[j] += t[j]; } }
        const float rs = row_rstd(s);
        unsigned* xh = (unsigned*)(F.ws + WS_XH) + (size_t)m * (DM / 2); f32x4 x[8];
        if (x_from_input) load_row(xin_ptr(F, m), F.lane, x); else load_row_h(xh, F.lane, x);
#pragma unroll
        for (int j = 0; j < 8; ++j) { const int col = 4 * F.lane + 256 * j;
            x[j] = x[j] + A[j] * (s[j] * rs);
            if (x_to_output) *(f32x4*)(OUTP(F) + (size_t)m * DM + col) = x[j];
            else { h4v o; o.x = (_Float16)clamp_h(x[j].x); o.y = (_Float16)clamp_h(x[j].y); o.z = (_Float16)clamp_h(x[j].z); o.w = (_Float16)clamp_h(x[j].w); *(h4v*)(xh + 2 * F.lane + 128 * j) = o; } }
        if (has_h) { const float rstd = row_rstd(x);
            const LAS float* Bp = lv + (bi * 3 + 1) * DM + 4 * F.lane; const LAS float* Cp = Bp + DM;
            bf16* hrow = H + (size_t)m * DM + 4 * F.lane;
#pragma unroll
            for (int j = 0; j < 8; ++j) { const f32x4 bb = *(const LAS f32x4*)(Bp + 256 * j), cc = *(const LAS f32x4*)(Cp + 256 * j); const f32x4 y = (x[j] * rstd) * bb + cc;
                v2u o; o.x = pk2(y.x, y.y); o.y = pk2(y.z, y.w); *(v2u*)(hrow + 256 * j) = o; } }
    }
}

__device__ __forceinline__ void tr_block(const float* W, int ldw, int K, int k0, int n_src0, bf16* WT, int n_dst0, LAS float* scr, int lane) {
#pragma unroll 8
    for (int i = 0; i < 32; ++i) { const int kk = 2 * i + (lane >> 5); scr[kk * 33 + (lane & 31)] = __builtin_nontemporal_load(W + (size_t)(k0 + kk) * ldw + n_src0 + (lane & 31)); }
    LDS_WAIT(); asm volatile("" ::: "memory");
    const int c = lane & 7;
#pragma unroll
    for (int j = 0; j < 4; ++j) { const int n = (lane >> 3) + 8 * j; const LAS float* s = scr + (8 * c) * 33 + n;
        v4u o; o.x = pk2(s[0 * 33], s[1 * 33]); o.y = pk2(s[2 * 33], s[3 * 33]); o.z = pk2(s[4 * 33], s[5 * 33]); o.w = pk2(s[6 * 33], s[7 * 33]);
        *(v4u*)(WT + (size_t)(n_dst0 + n) * K + k0 + 8 * c) = o; }
    LDS_WAIT(); asm volatile("" ::: "memory");
}
__device__ __forceinline__ int win_src_col(int d) {
    if (d < 512) return d;
    if (d < 768) return 1024 + (d - 512);
    if (d < 1280) return 4608 + (d - 768);
    if (d < 1792) return 5120 + (d - 1280);
    if (d < 7936) return 5632 + (d - 1792);
    if (d < 11008) return 1536 + (d - 7936);
    if (d < 11520) return 512 + (d - 11008);
    return 1280 + (d - 11520);
}
__device__ __forceinline__ void p1_weights(Frame& F, int l, int wset) {
    LAS float* scr = (LAS float*)(F.lds + F.wave * 8704);
    const int gw = F.bid * NWAVES + F.wave, NGW = F.G * NWAVES;
    constexpr int I_A = 368 * 32, I_B = 2048, I_C2 = 2048, I_D = 352 * 32, I_E = 64 * 88, NIT = I_A + I_B + I_C2 + I_D + I_E;
    unsigned char* wb = F.ws + WS_WSET + (size_t)wset * WSET_BYTES;
    bf16* WIN = (bf16*)(wb + WO_WIN); bf16* WBR = (bf16*)(wb + WO_WBR); bf16* WOUT = (bf16*)(wb + WO_WOUT); bf16* WUP = (bf16*)(wb + WO_WUP); bf16* WDN = (bf16*)(wb + WO_WDN);
    for (int it = gw; it < NIT; it += NGW) {
        int r = it;
        if (r < I_A) { const int nb = r / 32, kb = r % 32; tr_block(INP(F, I_WIN) + (size_t)l * DM * NIN, NIN, DM, 64 * kb, win_src_col(32 * nb), WIN, 32 * nb, scr, F.lane); continue; } r -= I_A;
        if (r < I_B) { const int nb = r / 32, kb = r % 32; tr_block(INP(F, I_WBR) + (size_t)l * DM * DM, DM, DM, 64 * kb, 32 * nb, WBR, 32 * nb, scr, F.lane); continue; } r -= I_B;
        if (r < I_C2) { const int nb = r / 32, kb = r % 32; tr_block(INP(F, I_WOUT) + (size_t)l * DM * DM, DM, DM, 64 * kb, 32 * nb, WOUT, 32 * nb, scr, F.lane); continue; } r -= I_C2;
        if (r < I_D) { const int nb = r / 32, kb = r % 32, d = 32 * nb, tl = d >> 8, wi = d & 255;
            tr_block(INP(F, I_WUP) + (size_t)l * DM * 2 * DFF, 2 * DFF, DM, 64 * kb, wi < 128 ? 128 * tl + wi : DFF + 128 * tl + (wi - 128), WUP, d, scr, F.lane); continue; } r -= I_D;
        { const int nb = r / 88, kb = r % 88; tr_block(INP(F, I_WDN) + (size_t)l * DFF * DM, DM, DFF, 64 * kb, 32 * nb, WDN, 32 * nb, scr, F.lane); }
    }
}
__device__ __forceinline__ void p0_filter_mlp(Frame& F) {
    const int gw = F.bid * NWAVES + F.wave, NGW = F.G * NWAVES, j = F.lane;
    for (int it = gw; it < DEPTH * 4352; it += NGW) {
        const int l = it / 4352, pos = it % 4352;
        const float* w1 = INP(F, I_HW1) + (size_t)l * 33 * 64; const float* b1 = INP(F, I_HB1) + l * 64; const float* fr = INP(F, I_HFREQ) + l * 128;
        const float* w2 = INP(F, I_HW2) + (size_t)l * 64 * 64; const float* b2 = INP(F, I_HB2) + l * 64;
        float* A2 = (float*)(F.ws + WS_A2) + (size_t)l * 4096 * 64; float* A2C = (float*)(F.ws + WS_A2C) + (size_t)l * 256 * 64;
        const int n = pos < 4096 ? 4096 : 256, i = pos < 4096 ? pos : pos - 4096;
        const float t = (float)i / (float)(n - 1), w = (6.283185307179586f / (float)n) * (float)i;
        float z = 0.f;
        if (j == 0) z = t;
        else if (j <= 16) { const float fb = 1e-4f + (float)(j - 1) * ((15.0f - 1e-4f) / 15.0f); z = cosf(fb * w); }
        else if (j <= 32) { const float fb = 1e-4f + (float)(j - 17) * ((15.0f - 1e-4f) / 15.0f); z = -sinf(fb * w); }
        float acc = b1[j];
#pragma unroll
        for (int f = 0; f < 33; ++f) acc += __shfl(z, f) * w1[f * 64 + j];
        const float a1 = sinf(fr[j] * acc);
        float acc2 = b2[j];
#pragma unroll 16
        for (int ii = 0; ii < 64; ++ii) acc2 += __shfl(a1, ii) * w2[ii * 64 + j];
        const float a2 = sinf(fr[64 + j] * acc2);
        if (pos < 4096) ((_Float16*)A2)[(size_t)pos * 64 + j] = (_Float16)a2;
        else A2C[(size_t)i * 64 + j] = a2;
    }
}

__device__ __forceinline__ void fft_twiddles(Frame& F) {
    cf2* TW = (cf2*)(F.ldsg + LDS_TW);
    float s, c; sincospif(-(float)F.tid * (1.0f / 4096.0f), &s, &c); cf2 w; w.x = c; w.y = s; TW[F.tid] = w;
}
template <int NBUF> __device__ __forceinline__ void fft_forward(Frame& F) {
    cf2* X0 = (cf2*)(F.ldsg + LDS_X0); cf2* X1 = (cf2*)(F.ldsg + LDS_X1); const cf2* TW = (const cf2*)(F.ldsg + LDS_TW);
    __syncthreads();
    if (NBUF == 2) fft_fwd_passA2(X0, X1, TW, F.tid); else fft_fwd_passA(X0, TW, F.tid);
    __syncthreads();
    if (NBUF == 2) fft_fwd_passB2(X0, X1, TW, F.tid); else fft_fwd_passB(X0, TW, F.tid);
    __syncthreads();
    if (NBUF == 2) { fft_fwd_passC(F.tid < 256 ? X0 : X1, F.tid & 255); } else { if (F.tid < 256) fft_fwd_passC(X0, F.tid); }
    __syncthreads();
}
template <int NBUF> __device__ __forceinline__ void fft_inverse(Frame& F) {
    cf2* X0 = (cf2*)(F.ldsg + LDS_X0); cf2* X1 = (cf2*)(F.ldsg + LDS_X1); const cf2* TW = (const cf2*)(F.ldsg + LDS_TW);
    __syncthreads();
    if (NBUF == 2) { fft_inv_passC(F.tid < 256 ? X0 : X1, F.tid & 255); } else { if (F.tid < 256) fft_inv_passC(X0, F.tid); }
    __syncthreads();
    fft_inv_passB(X0, TW, F.tid); if (NBUF == 2) fft_inv_passB(X1, TW, F.tid);
    __syncthreads();
    fft_inv_passA(X0, TW, F.tid); if (NBUF == 2) fft_inv_passA(X1, TW, F.tid);
    __syncthreads();
}

__device__ __forceinline__ void filter_pair(Frame& F, int l, int c0, int buf) {
    asm volatile("" : "+v"(F.tid)); F.lane = F.tid & 63;
    cf2* X0 = (cf2*)(F.ldsg + LDS_X0); cf2* X1 = (cf2*)(F.ldsg + LDS_X1);
    LAS float* XF0 = (LAS float*)(F.lds + LDS_X0); LAS float* XF1 = (LAS float*)(F.lds + LDS_X1);
    LAS float* W3S = (LAS float*)(F.lds + LDS_SM);
    LAS float* RED = (LAS float*)(F.lds + LDS_SM + 2048);
    const float* w3 = INP(F, I_HW3) + (size_t)l * 64 * 4096;
    const float* A2 = (const float*)(F.ws + WS_A2) + (size_t)l * 4096 * 64; const float* A2C = (const float*)(F.ws + WS_A2C) + (size_t)l * 256 * 64;
    const int lane = F.lane, n = lane & 15, q4 = lane >> 4;
    __syncthreads();
    { const int e8 = F.tid >> 6, kk = F.tid & 63; W3S[e8 * 64 + kk] = w3[(size_t)kk * 4096 + ((e8 >> 1) & 1) * 2048 + (e8 & 1) * 1024 + c0 + (e8 >> 2)]; }
    if (F.tid == 0) { cf2 zz; zz.x = 0.f; zz.y = 0.f; X0[PADI(4096)] = zz; X1[PADI(4096)] = zz; }
    const int n7 = n & 7; const int colb = ((n7 >> 1) & 1) * 2048 + (n7 & 1) * 1024 + c0 + ((n7 >> 2) & 1);
    h8v bfr[2];
#pragma unroll
    for (int s = 0; s < 2; ++s) {
#pragma unroll
        for (int j = 0; j < 8; ++j) bfr[s][j] = (_Float16)w3[(size_t)(32 * s + 8 * q4 + j) * 4096 + colb]; }
    const float dstep = (HY_MAX_DECAY - HY_MIN_DECAY) / 2047.0f;
    const int ch = (n7 >> 2) & 1, ord = n7 & 1, dir = (n7 >> 1) & 1; const bool up = n >= 8;
    const float del = fabsf(HY_MIN_DECAY + (float)(ord * 1024 + c0 + ch) * dstep);
    LAS float* XF = ch ? XF1 : XF0;
    float asum = 0.f;
#pragma unroll 4
    for (int i = 0; i < 32; ++i) {
        const int pos0 = 16 * (F.wave + 8 * i);
        const _Float16* aph = (const _Float16*)A2 + (size_t)(pos0 + n) * 64 + 8 * q4;
        f32x4 acc = (f32x4){0.f, 0.f, 0.f, 0.f};
#pragma unroll
        for (int s = 0; s < 2; ++s) { const h8v ah = *(const h8v*)(aph + 32 * s); acc = __builtin_amdgcn_mfma_f32_16x16x32_f16(ah, bfr[s], acc, 0, 0, 0); }
        {
            const float av[2] = {up ? acc[2] : acc[0], up ? acc[3] : acc[1]};
#pragma unroll
            for (int rr = 0; rr < 2; ++rr) { const int pos = pos0 + 4 * q4 + (up ? 2 : 0) + rr; const float t = (float)pos * (1.0f / 4095.0f); const float val = av[rr] * __builtin_amdgcn_exp2f(-t * del * 1.4426950408889634f);
                const bool bad = (dir != 0) && (pos == 0); const int idx = bad ? 4096 : (dir == 0 ? pos : 8192 - pos); const float vs = bad ? 0.f : val;
                asum += fabsf(vs); XF[2 * PADI(idx) + ord] = vs; }
        }
    }
    asum += __shfl_xor(asum, 16); asum += __shfl_xor(asum, 32); asum += __shfl_xor(asum, 2); asum += __shfl_xor(asum, 8);
    if (q4 == 0 && n < 8 && dir == 0) RED[F.wave * 4 + ch * 2 + ord] = asum;
    __syncthreads();
    float tot[4];
#pragma unroll
    for (int e = 0; e < 4; ++e) { float t = 0.f;
#pragma unroll
        for (int w = 0; w < 8; ++w) t += RED[w * 4 + e];
        tot[e] = 1.0f / t; }
    cf2* Xa = X0 + PADI(F.tid); cf2* Xb = X1 + PADI(F.tid);
#pragma unroll 4
    for (int i = 0; i < 16; ++i) { cf2 a = Xa[528 * i]; a.x *= tot[0]; a.y *= tot[1]; Xa[528 * i] = a; cf2 b = Xb[528 * i]; b.x *= tot[2]; b.y *= tot[3]; Xb[528 * i] = b; }
    fft_forward<2>(F);
    unsigned* KS = (unsigned*)(F.ws + WS_KSPEC + (size_t)buf * KSPEC_BUF) + (size_t)c0 * 2 * 8192 + F.tid;
#pragma unroll 2
    for (int i = 0; i < 16; ++i) { const int p = F.tid + 512 * i, pb = PADI(fft_conj_pos(p));
        const cf2 f = Xa[528 * i], g = X0[pb], f2 = Xb[528 * i], g2 = X1[pb];
        f32x2v k0, k1;
        k0.x = 0.5f * (f.x + g.x); k0.y = 0.5f * (f.y - g.y); k1.x = 0.5f * (f.y + g.y); k1.y = -0.5f * (f.x - g.x);
        KS[512 * i] = pack_h2(k0.x, k0.y); KS[8192 + 512 * i] = pack_h2(k1.x, k1.y);
        k0.x = 0.5f * (f2.x + g2.x); k0.y = 0.5f * (f2.y - g2.y); k1.x = 0.5f * (f2.y + g2.y); k1.y = -0.5f * (f2.x - g2.x);
        KS[16384 + 512 * i] = pack_h2(k0.x, k0.y); KS[16384 + 8192 + 512 * i] = pack_h2(k1.x, k1.y); }
    if (l + 1 < DEPTH) { const int cc = F.tid >> 8, pos = F.tid & 255; const f32x4* ar = (const f32x4*)(A2C + (size_t)pos * 64);
      const LAS float* W = W3S + cc * 256;
      float h0 = 0.f, h1 = 0.f, h2 = 0.f, h3 = 0.f;
#pragma unroll 4
      for (int q = 0; q < 16; ++q) { const f32x4 a = ar[q];
          const f32x4 u0 = *(const LAS f32x4*)(W + 0 * 64 + 4 * q), u1 = *(const LAS f32x4*)(W + 1 * 64 + 4 * q), u2 = *(const LAS f32x4*)(W + 2 * 64 + 4 * q), u3 = *(const LAS f32x4*)(W + 3 * 64 + 4 * q);
          h0 += (a.x * u0.x + a.y * u0.y) + (a.z * u0.z + a.w * u0.w); h1 += (a.x * u1.x + a.y * u1.y) + (a.z * u1.z + a.w * u1.w);
          h2 += (a.x * u2.x + a.y * u2.y) + (a.z * u2.z + a.w * u2.w); h3 += (a.x * u3.x + a.y * u3.y) + (a.z * u3.z + a.w * u3.w); }
      const float del0 = fabsf(HY_MIN_DECAY + (float)(c0 + cc) * dstep), del1 = fabsf(HY_MIN_DECAY + (float)(1024 + c0 + cc) * dstep);
      const float t = (float)pos * (1.0f / 255.0f), d0 = __builtin_amdgcn_exp2f(-t * del0 * 1.4426950408889634f), d1 = __builtin_amdgcn_exp2f(-t * del1 * 1.4426950408889634f);
      const float f0 = h0 * d0, f1 = h1 * d1, b0 = h2 * d0, b1 = h3 * d1;
      float c0s = fabsf(f0), c1s = fabsf(f1); if (pos >= 1) { c0s += fabsf(b0); c1s += fabsf(b1); }
      c0s = wave_sum(c0s); c1s = wave_sum(c1s);
      __syncthreads();
      if (F.lane == 0) { RED[F.wave * 2] = c0s; RED[F.wave * 2 + 1] = c1s; }
      __syncthreads();
      float u0 = 0.f, u1 = 0.f;
#pragma unroll
      for (int w = 0; w < 4; ++w) { u0 += RED[(4 * cc + w) * 2]; u1 += RED[(4 * cc + w) * 2 + 1]; }
      const float q0 = 1.0f / u0, q1 = 1.0f / u1;
      LAS float* KCS = XF0 + cc * 1024;
      KCS[pos] = f0 * q0; KCS[512 + pos] = f1 * q1;
      if (pos >= 1) { KCS[512 - pos] = b0 * q0; KCS[512 + 512 - pos] = b1 * q1; } else { KCS[256] = 0.f; KCS[512 + 256] = 0.f; }
      __syncthreads();
      float* KC = (float*)(F.ws + WS_KC + (size_t)buf * KC_BUF);
#pragma unroll
      for (int e = 0; e < 4; ++e) { const int idx = F.tid + 512 * e, c2 = idx >> 10, o2 = (idx >> 9) & 1, d = idx & 511; KC[(size_t)(o2 * 1024 + c0 + c2) * 512 + d] = XF0[idx]; }
      __syncthreads();
    }
}

__device__ __forceinline__ float conv3_at(const bf16* u, int t, int n, float w0, float w1, float w2, float bias) {
    const float cur = bf2f(u[t]); const float pv = bf2f(u[t - 1]), nv = bf2f(u[t + 1]);
    const float prv = t > 0 ? pv : 0.f; const float nxt = t < n - 1 ? nv : 0.f;
    return w0 * prv + w1 * cur + w2 * nxt + bias;
}
struct Raw8 { v4u r; float prv, nxt; };
__device__ __forceinline__ Raw8 load_raw8(const bf16* seq, int tid) {
    Raw8 x; const bf16* p = seq + 8 * tid; x.r = *(const v4u*)p;
    const float pv = bf2f(p[-1]), nv = bf2f(p[8]);
    x.prv = tid > 0 ? pv : 0.f; x.nxt = tid < 511 ? nv : 0.f; return x;
}
__device__ __forceinline__ void conv8(const Raw8& x, float w0, float w1, float w2, float bias, float (&o)[8]) {
    float e[10]; e[0] = x.prv; e[9] = x.nxt;
    e[1] = blo(x.r.x); e[2] = bhi(x.r.x); e[3] = blo(x.r.y); e[4] = bhi(x.r.y); e[5] = blo(x.r.z); e[6] = bhi(x.r.z); e[7] = blo(x.r.w); e[8] = bhi(x.r.w);
#pragma unroll
    for (int j = 0; j < 8; ++j) o[j] = w0 * e[j] + w1 * e[j + 1] + w2 * e[j + 2] + bias;
}
__device__ __forceinline__ void fft_passC_conv_h2(cf2* X, const unsigned (&kp)[32], int g) {
    cf2* Xp = X + 33 * g; cf2 v[32], w[32];
#pragma unroll
    for (int q = 0; q < 32; ++q) v[q] = Xp[q];
    dft_reg<32, 5, -1>(v);
#pragma unroll
    for (int q = 0; q < 32; ++q) { const h2v h = __builtin_bit_cast(h2v, kp[q]); const cf2 k = {(float)h.x, (float)h.y}; w[q] = cmul(v[bitrev_c(q, 5)], k); }
    dft_reg<32, 5, +1>(w);
#pragma unroll
    for (int q = 0; q < 32; ++q) Xp[q] = w[bitrev_c(q, 5)];
}
__device__ __forceinline__ void fft_conv2(Frame& F, const unsigned* K) {
    cf2* X0 = (cf2*)(F.ldsg + LDS_X0); cf2* X1 = (cf2*)(F.ldsg + LDS_X1); const cf2* TW = (const cf2*)(F.ldsg + LDS_TW);
    __syncthreads();
    fft_fwd_passA2_zp(X0, X1, TW, F.tid);
    __syncthreads();
    const int gC = 32 * F.wave + (F.lane & 31);
    unsigned kp[32];
    { const v4u* Kp = (const v4u*)(K + 32 * gC);
#pragma unroll
      for (int q = 0; q < 8; ++q) { const v4u t = Kp[q]; kp[4 * q] = t.x; kp[4 * q + 1] = t.y; kp[4 * q + 2] = t.z; kp[4 * q + 3] = t.w; } }
    FFT_PIN();
    fft_fwd_passB2(X0, X1, TW, F.tid);
    asm volatile("s_waitcnt lgkmcnt(0)" ::: "memory"); __builtin_amdgcn_wave_barrier();
    fft_passC_conv_h2(F.lane < 32 ? X0 : X1, kp, gC);
    asm volatile("s_waitcnt lgkmcnt(0)" ::: "memory"); __builtin_amdgcn_wave_barrier();
    fft_inv_passB2(X0, X1, TW, F.tid);
    __syncthreads();
    fft_inv_passA2_half(X0, X1, TW, F.tid);
    __syncthreads();
}
__device__ __forceinline__ void hyena_pair(Frame& F, int l, int c0, int buf, bool with_ctx) {
    cf2* X0 = (cf2*)(F.ldsg + LDS_X0); cf2* X1 = (cf2*)(F.ldsg + LDS_X1);
    const bf16* UT = (const bf16*)(F.ws + WS_UT);
    const float* cw = INP(F, I_HCW) + (size_t)l * 3 * 3072; const float* cb = INP(F, I_HCB) + (size_t)l * 3072;
    bf16* YH = (bf16*)(F.ws + WS_Y);
    const float* KC = (const float*)(F.ws + WS_KC + (size_t)buf * KC_BUF);
    unsigned op[4][4]; unsigned opc[2] = {0u, 0u};
#pragma unroll
    for (int b = 0; b < 4; ++b)
#pragma unroll
        for (int j = 0; j < 4; ++j) op[b][j] = 0u;
#pragma unroll 1
    for (int which = 0; which < 2; ++which) {
        asm volatile("" : "+v"(F.tid)); F.lane = F.tid & 63;
        const int c = c0 + which;
        const bf16* uv = UT + (size_t)(U_HY + c) * MT; const bf16* u1 = UT + (size_t)(U_HY + 1024 + c) * MT; const bf16* u2 = UT + (size_t)(U_HY + 2048 + c) * MT;
        const Raw8 r0 = load_raw8(uv + 0 * SEQ, F.tid), r1 = load_raw8(uv + 1 * SEQ, F.tid), r2 = load_raw8(uv + 2 * SEQ, F.tid), r3 = load_raw8(uv + 3 * SEQ, F.tid);
        const float vw0 = cw[c], vw1 = cw[3072 + c], vw2 = cw[6144 + c], vb = cb[c];
        const float aw0 = cw[1024 + c], aw1 = cw[3072 + 1024 + c], aw2 = cw[6144 + 1024 + c], ab = cb[1024 + c];
        const float bw0 = cw[2048 + c], bw1 = cw[3072 + 2048 + c], bw2 = cw[6144 + 2048 + c], bb = cb[2048 + c];
        const float sk0 = INP(F, I_HSKIP)[(size_t)l * 2048 + c], sk1 = INP(F, I_HSKIP)[(size_t)l * 2048 + 1024 + c];
        const unsigned* K0 = (const unsigned*)(F.ws + WS_KSPEC + (size_t)buf * KSPEC_BUF) + (size_t)c * 2 * 8192; const unsigned* K1 = K0 + 8192;
        const cf2 zero = {0.f, 0.f};
        cf2* Xa = X0 + PADI(8 * F.tid); cf2* Xb = X1 + PADI(8 * F.tid);
        FFT_PIN();
        __syncthreads();
        float v[4][8];
        { conv8(r0, vw0, vw1, vw2, vb, v[0]); conv8(r1, vw0, vw1, vw2, vb, v[1]); conv8(r2, vw0, vw1, vw2, vb, v[2]); conv8(r3, vw0, vw1, vw2, vb, v[3]); }
#pragma unroll
        for (int j = 0; j < 8; ++j) { cf2 a, b; a.x = v[0][j]; a.y = v[1][j]; b.x = v[2][j]; b.y = v[3][j]; Xa[j] = a; Xb[j] = b; }
        Raw8 xr[4];
#pragma unroll
        for (int b = 0; b < 4; ++b) xr[b] = load_raw8(u1 + b * SEQ, F.tid);
        fft_conv2(F, K0);
        float z[4][8];
        { float x1c[4][8];
#pragma unroll
          for (int b = 0; b < 4; ++b) conv8(xr[b], aw0, aw1, aw2, ab, x1c[b]);
#pragma unroll
          for (int j = 0; j < 8; ++j) { const cf2 ya = Xa[j], yb = Xb[j];
              z[0][j] = x1c[0][j] * (ya.x * (1.0f / 8192.0f) + sk0 * v[0][j]); z[1][j] = x1c[1][j] * (ya.y * (1.0f / 8192.0f) + sk0 * v[1][j]);
              z[2][j] = x1c[2][j] * (yb.x * (1.0f / 8192.0f) + sk0 * v[2][j]); z[3][j] = x1c[3][j] * (yb.y * (1.0f / 8192.0f) + sk0 * v[3][j]);
              cf2 a, b; a.x = z[0][j]; a.y = z[1][j]; b.x = z[2][j]; b.y = z[3][j]; Xa[j] = a; Xb[j] = b; } }
#pragma unroll
        for (int b = 0; b < 4; ++b) xr[b] = load_raw8(u2 + b * SEQ, F.tid);
        fft_conv2(F, K1);
        const int t = F.tid & 255, hf = F.tid >> 8, b0 = 2 * hf;
        const float kf0 = KC[(size_t)(0 * 1024 + c) * 512 + F.tid], kf1 = KC[(size_t)(1 * 1024 + c) * 512 + F.tid];
        float cv[2], cx1[2], cx2[2];
#pragma unroll
        for (int e = 0; e < 2; ++e) { const int so = ML + (b0 + e) * CTXL; cv[e] = conv3_at(uv + so, t, CTXL, vw0, vw1, vw2, vb); cx1[e] = conv3_at(u1 + so, t, CTXL, aw0, aw1, aw2, ab); cx2[e] = conv3_at(u2 + so, t, CTXL, bw0, bw1, bw2, bb); }
        { float x2c[4][8];
#pragma unroll
          for (int b = 0; b < 4; ++b) conv8(xr[b], bw0, bw1, bw2, bb, x2c[b]);
#pragma unroll
          for (int j = 0; j < 8; ++j) { const cf2 ya = Xa[j], yb = Xb[j];
              const float o0 = x2c[0][j] * (ya.x * (1.0f / 8192.0f) + sk1 * z[0][j]), o1 = x2c[1][j] * (ya.y * (1.0f / 8192.0f) + sk1 * z[1][j]);
              const float o2 = x2c[2][j] * (yb.x * (1.0f / 8192.0f) + sk1 * z[2][j]), o3 = x2c[3][j] * (yb.y * (1.0f / 8192.0f) + sk1 * z[3][j]);
              if (which == 0) { const int sh = (j >> 2) * 16; op[0][j & 3] |= f2bf(o0) << sh; op[1][j & 3] |= f2bf(o1) << sh; op[2][j & 3] |= f2bf(o2) << sh; op[3][j & 3] |= f2bf(o3) << sh; }
              else { const size_t tt = (size_t)(8 * F.tid + j);
                  const int sh = (j >> 2) * 16;
                  *(unsigned*)(YH + ((size_t)0 * SEQ + tt) * DM + c0) = ((op[0][j & 3] >> sh) & 0xffffu) | (f2bf(o0) << 16); *(unsigned*)(YH + ((size_t)1 * SEQ + tt) * DM + c0) = ((op[1][j & 3] >> sh) & 0xffffu) | (f2bf(o1) << 16);
                  *(unsigned*)(YH + ((size_t)2 * SEQ + tt) * DM + c0) = ((op[2][j & 3] >> sh) & 0xffffu) | (f2bf(o2) << 16); *(unsigned*)(YH + ((size_t)3 * SEQ + tt) * DM + c0) = ((op[3][j & 3] >> sh) & 0xffffu) | (f2bf(o3) << 16); } } }
        __syncthreads();
        if (!with_ctx) continue;
        LAS float* kr = (LAS float*)(F.lds + LDS_X0);
        LAS f32x4* vv4 = (LAS f32x4*)(F.lds + LDS_X0 + 8192);
        LAS f32x4* zz4 = (LAS f32x4*)(F.lds + LDS_X0 + 12288);
        LAS f32x4* part = (LAS f32x4*)(F.lds + LDS_X0 + 16384);
        { const int ri = (512 - F.tid) & 511; kr[ri] = kf0; kr[ri + 512] = kf0; kr[1024 + ri] = kf1; kr[1024 + ri + 512] = kf1; }
        float zc[2];
#pragma unroll
        for (int e = 0; e < 2; ++e) ((LAS float*)vv4)[t * 4 + b0 + e] = cv[e];
        __syncthreads();
#define CTX_CONV(KR, SRC) do { f32x4 acc = (f32x4){0.f, 0.f, 0.f, 0.f}; \
          _Pragma("unroll 2") for (int s = 128 * hf; s < 128 * hf + 128; s += 8) { const LAS float* kp = (KR) + ((s - t) & 511); float k8[8]; f32x4 v8[8]; \
              _Pragma("unroll") for (int jj = 0; jj < 8; ++jj) { k8[jj] = kp[jj]; v8[jj] = (SRC)[s + jj]; } \
              FFT_PIN(); \
              _Pragma("unroll") for (int jj = 0; jj < 8; ++jj) acc += k8[jj] * v8[jj]; } \
          part[hf * 256 + t] = acc; } while (0)
        CTX_CONV(kr, vv4);
        __syncthreads();
#pragma unroll
        for (int e = 0; e < 2; ++e) { const float y = ((LAS float*)part)[t * 4 + b0 + e] + ((LAS float*)part)[(256 + t) * 4 + b0 + e];
            zc[e] = cx1[e] * (y + sk0 * cv[e]); ((LAS float*)zz4)[t * 4 + b0 + e] = zc[e]; }
        __syncthreads();
        CTX_CONV(kr + 1024, zz4);
#undef CTX_CONV
        __syncthreads();
#pragma unroll
        for (int e = 0; e < 2; ++e) { const float y = ((LAS float*)part)[t * 4 + b0 + e] + ((LAS float*)part)[(256 + t) * 4 + b0 + e];
            const unsigned o = f2bf(cx2[e] * (y + sk1 * zc[e]));
            if (which == 0) opc[e] = o; else *(unsigned*)(YH + (size_t)(ML + (b0 + e) * CTXL + t) * DM + c0) = opc[e] | (o << 16); }
    }
    __syncthreads();
}
constexpr int AT_TILE = 35840, AT_K = 0, AT_V = 17408, AT_RPB = 2 * AT_TILE, AT_ROPE = AT_RPB + 2048, AT_END = AT_ROPE + 16384;
constexpr float ATT_SCALE2 = 0.08838834764831845f * 1.4426950408889634f;
__device__ __forceinline__ void attn_load_rope(Frame& F) {
    const f32x2v* rope = (const f32x2v*)(F.ws + WS_ROPE); LAS f32x2v* R = (LAS f32x2v*)(F.lds + AT_ROPE);
    __syncthreads();
    for (int e = F.tid; e < 2048; e += NTHR) R[e] = rope[e];
    __syncthreads();
}
#define ATT_PIN() __builtin_amdgcn_sched_barrier(0)
struct AttnTileRegs { bf16x8 ka, kb, v0, v1; };
__device__ __forceinline__ void attn_unit(Frame& F, int l, int u) {
    asm volatile("" : "+v"(F.tid)); F.lane = F.tid & 63;
    const bf16* P = (const bf16*)(F.ws + WS_P); const bf16* UT = (const bf16*)(F.ws + WS_UT);
    int mode, b, h, qtok0, klo, khi, qcol, kcol, vrow, qr0 = 0; bf16* Y; bool has_sink = false; float sink2 = 0.f;
    if (u < 256) { mode = 0; int p, blk; if (u < 32) { p = u >> 1; blk = (u & 1) ? 15 : 0; } else { const int t = u - 32; p = t / 14; blk = 1 + (t - 14 * p); } b = p >> 2; h = p & 3; qtok0 = b * SEQ + blk * 256;
        const int lo = blk * 256 - 128, hi = blk * 256 + 384; klo = b * SEQ + (lo < 0 ? 0 : lo); khi = b * SEQ + (hi > SEQ ? SEQ : hi);
        qcol = P_SWQ + h * 128; kcol = P_SWK + (h >> 1) * 128; vrow = U_SWV + (h >> 1) * 128; Y = (bf16*)(F.ws + WS_Y) + Y_SW; has_sink = true; sink2 = INP(F, I_SINK)[l * 4 + h] * 1.4426950408889634f; }
    else if (u < 512) { mode = 1; const int v = u - 256; int p, rq; if (v < 32) { p = v >> 1; rq = (v & 1) ? 15 : 0; } else { const int t = v - 32; p = t / 14; rq = 1 + (t - 14 * p); } b = p >> 2; h = p & 3; qr0 = 4 * rq; qtok0 = b * SEQ + qr0 * 64;
        int rs0 = qr0 - 4; rs0 = rs0 < 0 ? 0 : (rs0 > 56 ? 56 : rs0); int rs3 = qr0 + 3 - 4; rs3 = rs3 < 0 ? 0 : (rs3 > 56 ? 56 : rs3);
        klo = b * SEQ + 64 * rs0; khi = b * SEQ + 64 * (rs3 + 8);
        qcol = P_NAQ + h * 128; kcol = P_NAK + h * 128; vrow = U_NAV + h * 128; Y = (bf16*)(F.ws + WS_Y) + Y_NA; }
    else { const int v = u - 512; b = v >> 3; const int hh = v & 7; qtok0 = ML + b * CTXL; klo = 0; khi = 0;
        if (hh < 4) { mode = 2; h = hh; qcol = P_NAQ + h * 128; kcol = P_NAK + h * 128; vrow = U_NAV + h * 128; Y = (bf16*)(F.ws + WS_Y) + Y_NA; }
        else { mode = 3; h = hh - 4; qcol = P_SWQ + h * 128; kcol = P_SWK + (h >> 1) * 128; vrow = U_SWV + (h >> 1) * 128; Y = (bf16*)(F.ws + WS_Y) + Y_SW; has_sink = true; sink2 = INP(F, I_SINK)[l * 4 + h] * 1.4426950408889634f; } }
    const int ctok0 = ML + b * CTXL;
    const int lane = F.lane, w = F.wave, n = lane & 15, q4 = lane >> 4;
    LAS unsigned char* lds = F.lds; const LAS f32x2v* ROPE = (const LAS f32x2v*)(lds + AT_ROPE); LAS float* RPB = (LAS float*)(lds + AT_RPB);
    const int nloc = (khi - klo) >> 6, ntile = 4 + nloc;
    const int skey = F.tid >> 3, scp = F.tid & 7, shalf = scp >> 2, sci = scp & 3, sd0 = shalf * 64 + sci * 8;
#define ATT_KTOK(ti) ((ti) < 4 ? ctok0 + 64 * (ti) : klo + 64 * ((ti) - 4))
#define ATT_ISSUE(R, ti) do { const int kt_ = ATT_KTOK(ti); const bf16* kp_ = P + (size_t)(kt_ + skey) * NP + kcol + sd0; (R).ka = *(const bf16x8*)kp_; (R).kb = *(const bf16x8*)(kp_ + 32); \
        (R).v0 = *(const bf16x8*)(UT + (size_t)(vrow + (F.tid >> 3)) * MT + kt_ + 8 * (F.tid & 7)); (R).v1 = *(const bf16x8*)(UT + (size_t)(vrow + 64 + (F.tid >> 3)) * MT + kt_ + 8 * (F.tid & 7)); } while (0)
#define ATT_WRITE(R, ti, bufo) do { if (mode == 0 && (ti) >= 4) { const int tk_ = (ATT_KTOK(ti) + skey) & (SEQ - 1); const int pos_ = shalf == 0 ? (tk_ >> 6) : (tk_ & 63); \
            _Pragma("unroll") for (int j = 0; j < 8; ++j) { const f32x2v cs = ROPE[pos_ * 32 + 8 * sci + j]; const float x1 = bf2f((bf16)(R).ka[j]), x2 = bf2f((bf16)(R).kb[j]); \
                (R).ka[j] = (short)f2bf(x1 * cs.x - x2 * cs.y); (R).kb[j] = (short)f2bf(x2 * cs.x + x1 * cs.y); } } \
        *(LAS bf16x8*)(lds + (bufo) + AT_K + skey * 272 + sd0 * 2) = (R).ka; *(LAS bf16x8*)(lds + (bufo) + AT_K + skey * 272 + sd0 * 2 + 64) = (R).kb; \
        *(LAS bf16x8*)(lds + (bufo) + AT_V + (F.tid >> 3) * 144 + (F.tid & 7) * 16) = (R).v0; *(LAS bf16x8*)(lds + (bufo) + AT_V + (64 + (F.tid >> 3)) * 144 + (F.tid & 7) * 16) = (R).v1; } while (0)
    AttnTileRegs R;
    ATT_ISSUE(R, 0);
    __syncthreads();
    if (mode == 1) { const float* rpb = INP(F, I_RPB) + (size_t)(l * 4 + h) * 15 * 31; for (int e = F.tid; e < 465; e += NTHR) RPB[e] = rpb[e] * 1.4426950408889634f; }
    const int wq0 = qtok0 + 32 * w;
    bf16x8 qf[2][4];
#pragma unroll
    for (int g = 0; g < 2; ++g) { const int qtok = wq0 + 16 * g + n; const bf16* qp = P + (size_t)qtok * NP + qcol + 8 * q4;
#pragma unroll
      for (int s = 0; s < 4; ++s) qf[g][s] = *(const bf16x8*)(qp + 32 * s);
      if (mode == 0) {
          const int tq = qtok & (SEQ - 1);
#pragma unroll
          for (int ax = 0; ax < 2; ++ax) { const int pos = ax == 0 ? (tq >> 6) : (tq & 63);
#pragma unroll
              for (int j = 0; j < 8; ++j) { const f32x2v cs = ROPE[pos * 32 + 8 * q4 + j];
                  const float x1 = bf2f((bf16)qf[g][2 * ax][j]), x2 = bf2f((bf16)qf[g][2 * ax + 1][j]);
                  qf[g][2 * ax][j] = (short)f2bf(x1 * cs.x - x2 * cs.y); qf[g][2 * ax + 1][j] = (short)f2bf(x2 * cs.x + x1 * cs.y); } } }
    }
    ATT_WRITE(R, 0, 0);
#pragma unroll
    for (int g = 0; g < 2; ++g)
#pragma unroll
        for (int s = 0; s < 4; ++s) { v4u t = __builtin_bit_cast(v4u, qf[g][s]); asm volatile("" : "+v"(t)); qf[g][s] = __builtin_bit_cast(bf16x8, t); }
    float m_run[2], lsum[2]; f32x4 o[2][8];
#pragma unroll
    for (int g = 0; g < 2; ++g) { m_run[g] = has_sink ? sink2 : -1e30f; lsum[g] = (has_sink && q4 == 0) ? 1.0f : 0.f;
#pragma unroll
        for (int d = 0; d < 8; ++d) o[g][d] = (f32x4){0.f, 0.f, 0.f, 0.f}; }
    const int qr = qr0 + (w >> 1);
    int rs = qr - 4; rs = rs < 0 ? 0 : (rs > 56 ? 56 : rs);
    __syncthreads();
    for (int ti = 0; ti < ntile; ++ti) {
        const bool is_ctx = ti < 4; const int ktok0 = ATT_KTOK(ti); const int bufo = (ti & 1) * AT_TILE;
        if (ti + 1 < ntile) ATT_ISSUE(R, ti + 1);
        bool active = true;
        int kr = 0;
        if (!is_ctx) {
            if (mode == 1) { kr = (ktok0 & (SEQ - 1)) >> 6; active = (kr >= rs) && (kr < rs + 8); }
            else if (mode == 0) active = (ktok0 <= wq0 + 31 + 128) && (ktok0 + 63 >= wq0 - 128);
        }
        if (active) {
            f32x4 sc[2][4];
            { bf16x8 kf[2][4];
              const LAS unsigned char* kbase = lds + bufo + AT_K + n * 272 + 16 * q4;
#pragma unroll
              for (int s = 0; s < 4; ++s) kf[0][s] = *(const LAS bf16x8*)(kbase + 64 * s);
#pragma unroll
              for (int kb = 0; kb < 4; ++kb) {
                  if (kb < 3) {
#pragma unroll
                      for (int s = 0; s < 4; ++s) kf[(kb + 1) & 1][s] = *(const LAS bf16x8*)(kbase + (kb + 1) * (16 * 272) + 64 * s); }
                  ATT_PIN();
                  f32x4 a0 = (f32x4){0.f, 0.f, 0.f, 0.f}, a1 = (f32x4){0.f, 0.f, 0.f, 0.f};
#pragma unroll
                  for (int s = 0; s < 4; ++s) { a0 = __builtin_amdgcn_mfma_f32_16x16x32_bf16(kf[kb & 1][s], qf[0][s], a0, 0, 0, 0); a1 = __builtin_amdgcn_mfma_f32_16x16x32_bf16(kf[kb & 1][s], qf[1][s], a1, 0, 0, 0); }
                  sc[0][kb] = a0; sc[1][kb] = a1;
                  ATT_PIN(); } }
            bf16x8 pf[2][2];
#pragma unroll
            for (int g = 0; g < 2; ++g) {
                const int qtok = wq0 + 16 * g + n;
                float tmax = -INFINITY;
                if (is_ctx || mode >= 2 || (mode == 0 && ktok0 >= wq0 - 97 && ktok0 <= wq0 + 65)) {
#pragma unroll
                    for (int kb = 0; kb < 4; ++kb)
#pragma unroll
                        for (int r = 0; r < 4; ++r) { const float v = sc[g][kb][r] * ATT_SCALE2; sc[g][kb][r] = v; tmax = fmaxf(tmax, v); }
                } else if (mode == 0) {
                    const int d0 = qtok - ktok0 - 4 * q4;
#pragma unroll
                    for (int kb = 0; kb < 4; ++kb)
#pragma unroll
                        for (int r = 0; r < 4; ++r) { const int dpos = d0 - (16 * kb + r); float v = sc[g][kb][r] * ATT_SCALE2; v = (dpos > 128 || dpos < -128) ? -INFINITY : v; sc[g][kb][r] = v; tmax = fmaxf(tmax, v); }
                } else {
                    const int qc = 32 * (w & 1) + 16 * g + n; int cs0 = qc - 8; cs0 = cs0 < 0 ? 0 : (cs0 > 48 ? 48 : cs0);
                    int e0 = 4 * q4 - cs0; asm volatile("" : "+v"(e0));
                    const LAS float* rb = RPB + (kr - qr + 7) * 31 + (4 * q4 - qc + 15);
                    float bias[4][4];
#pragma unroll
                    for (int kb = 0; kb < 4; ++kb)
#pragma unroll
                        for (int r = 0; r < 4; ++r) bias[kb][r] = rb[16 * kb + r];
#pragma unroll
                    for (int kb = 0; kb < 4; ++kb)
#pragma unroll
                        for (int r = 0; r < 4; ++r) { float v = sc[g][kb][r] * ATT_SCALE2 + bias[kb][r]; v = ((unsigned)(e0 + 16 * kb + r) >= 16u) ? -INFINITY : v; sc[g][kb][r] = v; tmax = fmaxf(tmax, v); }
                }
                tmax = fmaxf(tmax, __shfl_xor(tmax, 16)); tmax = fmaxf(tmax, __shfl_xor(tmax, 32));
                const float m_new = fmaxf(m_run[g], tmax); const float alpha = __builtin_amdgcn_exp2f(m_run[g] - m_new); m_run[g] = m_new;
                float ps = 0.f;
#pragma unroll
                for (int kb = 0; kb < 4; ++kb)
#pragma unroll
                    for (int r = 0; r < 4; ++r) { const float p = __builtin_amdgcn_exp2f(sc[g][kb][r] - m_new); sc[g][kb][r] = p; ps += p; }
                lsum[g] = lsum[g] * alpha + ps;
#pragma unroll
                for (int d = 0; d < 8; ++d) o[g][d] = o[g][d] * alpha;
#pragma unroll
                for (int s2 = 0; s2 < 2; ++s2) { v4u t; t.x = pk2(sc[g][2 * s2][0], sc[g][2 * s2][1]); t.y = pk2(sc[g][2 * s2][2], sc[g][2 * s2][3]); t.z = pk2(sc[g][2 * s2 + 1][0], sc[g][2 * s2 + 1][1]); t.w = pk2(sc[g][2 * s2 + 1][2], sc[g][2 * s2 + 1][3]);
                    pf[g][s2] = __builtin_bit_cast(bf16x8, t); }
            }
            { v2u vr[2][4];
              const LAS unsigned char* vbase = lds + bufo + AT_V + n * 144 + 8 * q4;
#pragma unroll
              for (int e = 0; e < 4; ++e) vr[0][e] = *(const LAS v2u*)(vbase + 64 * (e >> 1) + 32 * (e & 1));
#pragma unroll
              for (int d = 0; d < 8; ++d) {
                  if (d < 7) {
#pragma unroll
                      for (int e = 0; e < 4; ++e) vr[(d + 1) & 1][e] = *(const LAS v2u*)(vbase + (d + 1) * (16 * 144) + 64 * (e >> 1) + 32 * (e & 1)); }
                  ATT_PIN();
#pragma unroll
                  for (int s2 = 0; s2 < 2; ++s2) { v4u t; t.x = vr[d & 1][2 * s2].x; t.y = vr[d & 1][2 * s2].y; t.z = vr[d & 1][2 * s2 + 1].x; t.w = vr[d & 1][2 * s2 + 1].y; const bf16x8 vf = __builtin_bit_cast(bf16x8, t);
                      o[0][d] = __builtin_amdgcn_mfma_f32_16x16x32_bf16(vf, pf[0][s2], o[0][d], 0, 0, 0); o[1][d] = __builtin_amdgcn_mfma_f32_16x16x32_bf16(vf, pf[1][s2], o[1][d], 0, 0, 0); }
                  ATT_PIN(); } }
        }
        __syncthreads();
        if (ti + 1 < ntile) ATT_WRITE(R, ti + 1, ((ti + 1) & 1) * AT_TILE);
        __syncthreads();
    }
#undef ATT_KTOK
#undef ATT_ISSUE
#undef ATT_WRITE
#pragma unroll
    for (int g = 0; g < 2; ++g) { float lt = lsum[g]; lt += __shfl_xor(lt, 16); lt += __shfl_xor(lt, 32);
        const float inv = 1.0f / lt;
        bf16* yp = Y + (size_t)(wq0 + 16 * g + n) * DM + h * 128 + 4 * q4;
#pragma unroll
        for (int d = 0; d < 8; ++d) { v2u t; t.x = pk2(o[g][d][0] * inv, o[g][d][1] * inv); t.y = pk2(o[g][d][2] * inv, o[g][d][3] * inv); *(v2u*)(yp + 16 * d) = t; } }
}

__device__ __forceinline__ void act_fixup(Frame& F, int l, int mrows) {
    const float* HP = (const float*)(F.ws + WS_HALO); const float* HU = (const float*)(F.ws + WS_HALO + HALO_ONE); const float* HA = (const float*)(F.ws + WS_HALO + 2 * HALO_ONE);
    bf16* ACT = (bf16*)(F.ws + WS_ACT);
    const float* cw = INP(F, I_FCW) + (size_t)l * 3 * DFF;
    const int ntile = mrows / 256, nit = ntile * 2 * (DFF / 4);
    for (int it = F.bid * NTHR + F.tid; it < nit; it += F.G * NTHR) {
        const int c4 = it % (DFF / 4), pe = it / (DFF / 4), e = pe & 1, pm = pe >> 1, t0 = pm * 256, seqlen = t0 < ML ? SEQ : CTXL;
        const bool open = e == 0 ? (t0 % seqlen) != 0 : ((t0 + 256) % seqlen) != 0;
        if (!open) continue;
        const int j = 4 * c4; const size_t ho = ((size_t)pm * 2 + e) * DFF + j;
        const f32x4 pp = *(const f32x4*)(HP + ho), uu = *(const f32x4*)(HU + ho);
        const f32x4 nb = e == 0 ? *(const f32x4*)(HA + ((size_t)(pm - 1) * 2 + 1) * DFF + j) : *(const f32x4*)(HA + ((size_t)(pm + 1) * 2 + 0) * DFF + j);
        const f32x4 w = *(const f32x4*)(cw + (e == 0 ? 0 : 2 * DFF) + j);
        float r[4];
#pragma unroll
        for (int q = 0; q < 4; ++q) { const float pre = pp[q] + w[q] * nb[q]; r[q] = pre * pg8::sigmoid_f(pre) * uu[q]; }
        v2u o; o.x = pk2(r[0], r[1]); o.y = pk2(r[2], r[3]);
        *(v2u*)(ACT + (size_t)(t0 + (e ? 255 : 0)) * DFF + j) = o;
    }
}
#ifndef MK_PER_PHASE
#define MK_PER_PHASE 0
#endif
constexpr int PH_PER_LAYER = 10, N_PHASES = 1 + PH_PER_LAYER * DEPTH;
__device__ __forceinline__ int ufence(int v) { asm volatile("" : "+v"(v)); return __builtin_amdgcn_readfirstlane(v); }
__device__ __forceinline__ int opq(int v) { return ufence(v); }
struct Args { const float* in[25]; float* out; unsigned char* ws; int ph_lo, ph_hi; };
__global__ void __launch_bounds__(NTHR, 2) hybrid_fwd(Args args) {
    extern __shared__ __attribute__((aligned(16))) unsigned char lds[];
    Frame F;
    F.lds = (LAS unsigned char*)lds; F.ldsg = lds;
    F.MISC = (volatile LAS unsigned*)(F.lds + MISC_OFF);
    F.tid = threadIdx.x; F.lane = F.tid & 63; F.wave = __builtin_amdgcn_readfirstlane(F.tid >> 6);
    F.G = gridDim.x; F.bid = blockIdx.x;
    F.ws = args.ws; F.ctl = (gu32*)(args.ws + WS_CTL); F.karg = (unsigned long long)__builtin_amdgcn_kernarg_segment_ptr();
    for (int u = F.tid; u < (LDS_BYTES - MISC_OFF) / 4; u += NTHR) ((LAS unsigned*)(F.lds + MISC_OFF))[u] = 0u;
    __syncthreads();
    XcdBarrier bar; bar.bar = (unsigned*)(F.ctl + CW_BAR); bar.x = 0; bar.st = nullptr;
#if !MK_PER_PHASE
    bar = xcd_barrier_post((unsigned*)(F.ctl + CW_BAR), F.MISC + 8, F.tid);
#endif
    const int lo = args.ph_lo, hi = args.ph_hi;
    const int MTr = ufence(MT);
#ifndef PHMASK
#define PHMASK 0x7ff
#endif
#define IN(k) (lo <= (k) && (k) < hi)
#define PHON(j) (((PHMASK) >> (j)) & 1)
#ifndef DBLMASK
#define DBLMASK 0
#endif
#define REPS(j) ((((DBLMASK) >> (j)) & 1) ? 2 : 1)
#define SEAM(k) do { if (IN(k) && IN((k) + 1)) { XcdBarrier b2_ = bar; b2_.bar = (unsigned*)(F.ws + WS_CTL) + CW_BAR; xcd_barrier(b2_, F.tid); } } while (0)
#define FENCE() do { asm volatile("" : "+v"(F.tid)); F.lane = F.tid & 63; F.wave = __builtin_amdgcn_readfirstlane(F.tid >> 6); F.bid = ufence(F.bid); F.G = ufence(F.G); \
    { const unsigned long long w_ = (unsigned long long)F.ws; const unsigned lo_ = (unsigned)ufence((int)(unsigned)w_), hi_ = (unsigned)ufence((int)(unsigned)(w_ >> 32)); F.ws = (unsigned char*)(GAS unsigned char*)(((unsigned long long)hi_ << 32) | lo_); }\
    { const unsigned lo_ = (unsigned)ufence((int)(unsigned)F.karg), hi_ = (unsigned)ufence((int)(unsigned)(F.karg >> 32)); F.karg = ((unsigned long long)hi_ << 32) | lo_; } } while (0)
#define H ((bf16*)(F.ws + WS_H))
#define Pb ((bf16*)(F.ws + WS_P))
#define UT ((bf16*)(F.ws + WS_UT))
#define WIN ((bf16*)(F.ws + WS_WSET + (size_t)wset * WSET_BYTES + WO_WIN))
#define WBR ((bf16*)(F.ws + WS_WSET + (size_t)wset * WSET_BYTES + WO_WBR))
#define WOUT ((bf16*)(F.ws + WS_WSET + (size_t)wset * WSET_BYTES + WO_WOUT))
#define WUP ((bf16*)(F.ws + WS_WSET + (size_t)wset * WSET_BYTES + WO_WUP))
#define WDN ((bf16*)(F.ws + WS_WSET + (size_t)wset * WSET_BYTES + WO_WDN))
#define YY ((bf16*)(F.ws + WS_Y))
#define T1 ((bf16*)(F.ws + WS_T1))
#define T2 ((bf16*)(F.ws + WS_T2))
#define MM ((bf16*)(F.ws + WS_MM))
#define MIX ((float*)(F.ws + WS_MIX))
#define AU ((bf16*)(F.ws + WS_AU))
#define ACT ((bf16*)(F.ws + WS_ACT))
#define SLAB ((_Float16*)(F.ws + WS_UT))

    if (PHON(0) && IN(0)) { FENCE(); p0_modvec(F); __syncthreads(); p0_filter_mlp(F); }
    SEAM(0);
    for (int l = 0; l < DEPTH; ++l) {
        const int pb = 1 + PH_PER_LAYER * l;
        const int mrows = (l == DEPTH - 1) ? ML : MTr;
        const int wset = l & 1, kbuf = l & 1;
        if (PHON(1) && IN(pb + 0)) for (int rep_ = 0; rep_ < REPS(1); ++rep_) { FENCE(); p1_weights(F, l, wset); if (l == 0) { rows_first(F); p1_modcomb(F); } }
        SEAM(pb + 0);
        if (PHON(2) && IN(pb + 1)) {
            FENCE(); fft_twiddles(F);
            for (int rep_ = 0; rep_ < REPS(11); ++rep_)
            if (F.G == 256 && l + 1 < DEPTH) {
#pragma unroll 1
                for (int i = 0; i < 3; ++i) { int pi = -1;
                    if (i == 0) pi = F.bid; else if (F.bid >= 56) { if (i == 1) pi = 256 + (F.bid - 56); else if (F.bid < 112) pi = 456 + (F.bid - 56); }
                    if (pi >= 0) filter_pair(F, l, 2 * pi, kbuf); }
            } else for (int pi = F.bid; pi < HYW / 2; pi += F.G) filter_pair(F, l, 2 * pi, kbuf);
            __syncthreads(); FENCE();
            for (int rep_ = 0; rep_ < REPS(2); ++rep_) {
            const int npart = (l == DEPTH - 1) ? 2 : 1; int cum = 0;
#pragma unroll 1
            for (int part = 0; part < npart; ++part) {
              FENCE();
              const int rows = opq(npart == 1 ? MT : (part == 0 ? ML : MC)), roff = (part == 0) ? 0 : ML, N1 = opq(part == 0 ? NP : P_NAQ), K1 = opq(DM);
              const int c = (F.bid + F.G - cum % F.G) % F.G; cum += (rows / 256) * (N1 / 256);
              pg8::Gemm g{H + (size_t)roff * DM, WIN, rows, N1, K1, K1, K1}; pg8::StaticOrder S; S.init(rows, N1, F.G, c); pg8::EpiBf16Gate E{Pb + (size_t)roff * NP, NP, P_GATE / 256};
              pg8::gemm_phase<pg8::EpiBf16Gate, pg8::StaticOrder, true, true>(F.lds, g, S, E, F.tid); }
#pragma unroll 1
            for (int part = 0; part < npart; ++part) {
              FENCE();
              const int toks = opq(npart == 1 ? MT : (part == 0 ? ML : MC)), toff = (part == 0) ? 0 : ML, choff = (part == 0) ? 0 : U_NAV, M2 = opq(part == 0 ? NU : NU - U_NAV), K2 = opq(DM);
              const int c = (F.bid + F.G - cum % F.G) % F.G; cum += (M2 / 256) * (toks / 256);
              pg8::Gemm g{WIN + (size_t)(NP + choff) * DM, H + (size_t)toff * DM, M2, toks, K2, K2, K2}; pg8::StaticOrder S; S.init(M2, toks, F.G, c); pg8::EpiBf16P E{UT + (size_t)choff * MT + toff, MT};
              pg8::gemm_phase<pg8::EpiBf16P, pg8::StaticOrder, true, true>(F.lds, g, S, E, F.tid); }
            }
        }
        SEAM(pb + 1);
        if (PHON(3) && IN(pb + 2)) {
            FENCE(); fft_twiddles(F);
            for (int rep_ = 0; rep_ < REPS(3); ++rep_)
            for (int pi = F.bid; pi < HYW / 2; pi += F.G) { const int s = pi >> 8, wv = pi & 255; const int pr = 64 * (wv & 7) + (wv >> 3) + 32 * s; hyena_pair(F, l, 2 * pr, kbuf, l + 1 < DEPTH); }
            FENCE(); attn_load_rope(F);
            for (int rep_ = 0; rep_ < REPS(12); ++rep_)
            { const int vcu = (F.G % 8 == 0) ? (F.bid % 8) * (F.G / 8) + F.bid / 8 : F.bid;
              for (int u = vcu; u < (l + 1 < DEPTH ? 544 : 512); u += F.G) attn_unit(F, l, u); }
        }
        SEAM(pb + 2);
        if (PHON(4) && IN(pb + 3)) for (int rep_ = 0; rep_ < REPS(4); ++rep_) {
            FENCE();
            { pg8::Gemm g{YY, WBR, mrows, DM, opq(DM), DM, DM}; pg8::StaticOrder S; S.init(mrows, DM, F.G, F.bid); pg8::EpiMergeK E{Pb + P_GATE, NP, MM, DM};
              pg8::gemm_phase<pg8::EpiMergeK, pg8::StaticOrder, true, true>(F.lds, g, S, E, F.tid); }
        }
        SEAM(pb + 3);
        if (PHON(5) && IN(pb + 4)) for (int rep_ = 0; rep_ < REPS(5); ++rep_) { FENCE();
            { pg8::Gemm g{MM, WOUT, ML, DM, DM, DM, DM}; pg8::StaticOrder S; S.init(ML, DM, F.G, F.bid); pg8::EpiBf16P E{(bf16*)MIX, DM};
              pg8::gemm_phase<pg8::EpiBf16P, pg8::StaticOrder, true, true>(F.lds, g, S, E, F.tid); }
            if (mrows > ML) { FENCE();
              pg8::Gemm g{MM + (size_t)ML * DM, WOUT, MC, DM, opq(DM / 4), DM, DM}; pg8::SplitOrder S; S.init(MC, DM, 4, F.G, F.bid); pg8::EpiF32Slab E{SLAB, DM, (size_t)MC * DM};
              pg8::gemm_phase<pg8::EpiF32Slab, pg8::SplitOrder, true, true>(F.lds, g, S, E, F.tid); } }
        SEAM(pb + 4);
        if (PHON(6) && IN(pb + 5)) { FENCE(); rows_residual(F, l, MIX, 0, mrows, l == 0, false); }
        SEAM(pb + 5);
        if (PHON(7) && IN(pb + 6)) for (int rep_ = 0; rep_ < REPS(7); ++rep_) { FENCE(); pg8::StaticOrder S; S.init(mrows, 2 * DFF, F.G, F.bid);
            pg8::EpiAct E{ACT, DFF, INP(F, I_FCW) + (size_t)l * 3 * DFF, INP(F, I_FCB) + (size_t)l * DFF, (float*)(F.ws + WS_HALO), (float*)(F.ws + WS_HALO + HALO_ONE), (float*)(F.ws + WS_HALO + 2 * HALO_ONE)};
#pragma unroll 1
            for (int ui = 0; ; ++ui) { pg8::OneUnit S1; if (!S.next(ui, S1.u)) break;
                pg8::Gemm g{H, WUP, mrows, 2 * DFF, opq(DM), DM, DM};
                pg8::gemm_phase<pg8::EpiAct, pg8::OneUnit, false, true>(F.lds, g, S1, E, F.tid); __syncthreads(); } }
        SEAM(pb + 6);
        if (PHON(8) && IN(pb + 7)) for (int rep_ = 0; rep_ < REPS(8); ++rep_) { FENCE(); act_fixup(F, l, mrows); }
        SEAM(pb + 7);
        if (PHON(9) && IN(pb + 8)) for (int rep_ = 0; rep_ < REPS(9); ++rep_) { FENCE();
            { pg8::Gemm g{ACT, WDN, ML, DM, DFF, DFF, DFF}; pg8::StaticOrder S; S.init(ML, DM, F.G, F.bid); pg8::EpiBf16P E{(bf16*)MIX, DM};
              pg8::gemm_phase<pg8::EpiBf16P, pg8::StaticOrder, true, true>(F.lds, g, S, E, F.tid); }
            if (mrows > ML) { FENCE();
              pg8::Gemm g{ACT + (size_t)ML * DFF, WDN, MC, DM, opq(DFF / 4), DFF, DFF}; pg8::SplitOrder S; S.init(MC, DM, 4, F.G, F.bid); pg8::EpiF32Slab E{SLAB, DM, (size_t)MC * DM};
              pg8::gemm_phase<pg8::EpiF32Slab, pg8::SplitOrder, true, true>(F.lds, g, S, E, F.tid); } }
        SEAM(pb + 8);
        if (PHON(10) && IN(pb + 9)) { FENCE(); rows_residual(F, l, MIX, 1, mrows, false, l + 1 == DEPTH); }
        SEAM(pb + 9);
    }
#undef IN
#undef SEAM
#undef H
#undef Pb
#undef UT
#undef WIN
#undef WBR
#undef WOUT
#undef WUP
#undef WDN
#undef YY
#undef T1
#undef T2
#undef MM
#undef MIX
#undef AU
#undef ACT
#undef SLAB
}

extern "C" void kernel_launch(void* const* d_in, const int* in_sizes, int n_in, void* d_out, int out_size, void* d_ws, size_t ws_size, hipStream_t stream) {
    static int grid = 0;
    if (grid == 0) {
        if (n_in != 25 || in_sizes[0] != ML * DM || out_size != ML * DM || ws_size < WS_END) { fprintf(stderr, "kernel_launch: unexpected shapes (n_in %d, in0 %d, out %d, ws %zu < %zu); nothing launched\n", n_in, n_in > 0 ? in_sizes[0] : -1, out_size, ws_size, (size_t)WS_END); grid = -1; return; }
        int dev = 0, cus = 0, per_cu = 0;
        if (hipGetDevice(&dev) != hipSuccess || hipDeviceGetAttribute(&cus, hipDeviceAttributeMultiprocessorCount, dev) != hipSuccess) { fprintf(stderr, "kernel_launch: device query failed\n"); grid = -1; return; }
        if (hipFuncSetAttribute((const void*)hybrid_fwd, hipFuncAttributeMaxDynamicSharedMemorySize, LDS_BYTES) != hipSuccess) { fprintf(stderr, "kernel_launch: hipFuncSetAttribute failed\n"); grid = -1; return; }
        if (hipOccupancyMaxActiveBlocksPerMultiprocessor(&per_cu, (const void*)hybrid_fwd, NTHR, LDS_BYTES) != hipSuccess || per_cu < 1) fprintf(stderr, "kernel_launch: note: occupancy query reports %d blocks per CU\n", per_cu);
        (void)hipGetLastError();
        grid = cus;
    }
    if (grid < 0) return;
    if (hipMemsetAsync((char*)d_ws + WS_CTL, 0, CTL_ZERO_BYTES, stream) != hipSuccess) { fprintf(stderr, "kernel_launch: memset failed\n"); return; }
    Args a{};
    for (int i = 0; i < 25; ++i) a.in[i] = (const float*)d_in[i];
    a.out = (float*)d_out; a.ws = (unsigned char*)d_ws;
#if MK_PER_PHASE
    for (int p = 0; p < N_PHASES; ++p) { a.ph_lo = p; a.ph_hi = p + 1; hipLaunchKernelGGL(hybrid_fwd, dim3(grid), dim3(NTHR), LDS_BYTES, stream, a); }
#else
    a.ph_lo = 0; a.ph_hi = N_PHASES; hipLaunchKernelGGL(hybrid_fwd, dim3(grid), dim3(NTHR), LDS_BYTES, stream, a);
#endif
    const hipError_t le = hipPeekAtLastError();
    if (le != hipSuccess) fprintf(stderr, "kernel_launch: launch failed: %s\n", hipGetErrorName(le));
}
```

```cpp
#include <hip/hip_runtime.h>
#include <cstdio>
#include <cstdint>
#include <cmath>
namespace pg8 {
#define PG8_LAS __attribute__((address_space(3)))
typedef unsigned short bf16_t;
typedef short bf16x8 __attribute__((ext_vector_type(8)));
typedef float f32x4 __attribute__((ext_vector_type(4)));
typedef unsigned u32x4 __attribute__((ext_vector_type(4)));
constexpr int BM = 256, BK = 64, HALF = 128, HTB = HALF * BK * 2  , STAGE_BYTES = 8 * HTB, NXCD = 8, WGM = 8;

__host__ __device__ __forceinline__ int lds_byte(int r, int c) { const int st = (r >> 4) * 2 + (c >> 5), rr = r & 15, cc = c & 31, ob = rr * 64 + cc * 2; return st * 1024 + (ob ^ (((ob >> 9) & 1) << 5)); }
__host__ __device__ __forceinline__ void stage_rc(int b, int& R, int& C) { const int st = b / 1024, sb = b % 1024, swz = sb ^ (((sb >> 9) & 1) << 5); R = (st >> 1) * 16 + swz / 64; C = (st & 1) * 32 + (swz % 64) / 2; }
__host__ __device__ __forceinline__ int perm32(int rho) { const int n = rho >> 4, i = rho & 15; return 8 * (i >> 2) + 4 * n + (i & 3); }

struct Unit { int pm, pn, ks; };
struct Gemm { const bf16_t* A; const bf16_t* Bt; int M, N, K, lda, ldb; };

struct StaticOrder {
    int nM, nN, nwg, G, c;
    __host__ __device__ __forceinline__ void init(int M, int N, int G_, int c_) { nM = M / BM; nN = N / BM; nwg = nM * nN; G = G_; c = c_; }
    __host__ __device__ __forceinline__ bool next(int i, Unit& u) const {
        const long L = (long)i * G + c; if (L >= nwg) return false;
        int wgid = (int)L; { const int q = nwg / NXCD, r = nwg % NXCD, xcd = wgid % NXCD, off = wgid / NXCD; wgid = (xcd < r ? xcd * (q + 1) : r * (q + 1) + (xcd - r) * q) + off; }
        const int nig = WGM * nN, gid = wgid / nig, fm = gid * WGM, gsz = (nM - fm) < WGM ? (nM - fm) : WGM;
        u.pm = fm + ((wgid % nig) % gsz); u.pn = (wgid % nig) / gsz; u.ks = 0; return true;
    }
    __device__ __forceinline__ void a_ready(const Unit&) const {}
    __device__ __forceinline__ void done(const Unit&) const {}
};

struct OneUnit {
    Unit u;
    __host__ __device__ __forceinline__ bool next(int i, Unit& o) const { if (i != 0) return false; o = u; return true; }
    __device__ __forceinline__ void a_ready(const Unit&) const {}
    __device__ __forceinline__ void done(const Unit&) const {}
};
struct SplitOrder {
    int nM, nN, S, nwg, G, c;
    __host__ __device__ __forceinline__ void init(int M, int N, int S_, int G_, int c_) { nM = M / BM; nN = N / BM; S = S_; nwg = nM * nN * S_; G = G_; c = c_; }
    __host__ __device__ __forceinline__ bool next(int i, Unit& u) const { const long L = (long)i * G + c; if (L >= nwg) return false; const int t = (int)L / S; u.ks = (int)L % S; u.pm = t % nM; u.pn = t / nM; return true; }
    __device__ __forceinline__ void a_ready(const Unit&) const {}
    __device__ __forceinline__ void done(const Unit&) const {}
};
__device__ __forceinline__ unsigned cvt_pk_bf16(float lo, float hi) { unsigned r; asm volatile("v_cvt_pk_bf16_f32 %0, %1, %2" : "=v"(r) : "v"(lo), "v"(hi)); return r; }
typedef float f32x2 __attribute__((ext_vector_type(2)));
__device__ __forceinline__ float bf_lo(unsigned u) { return __uint_as_float(u << 16); }
__device__ __forceinline__ float bf_hi(unsigned u) { return __uint_as_float(u & 0xffff0000u); }
__device__ __forceinline__ float sigmoid_f(float x) { return __builtin_amdgcn_rcpf(1.0f + __builtin_amdgcn_exp2f(-1.44269504f * x)); }
struct EpiBf16P {
    static constexpr bool PERM = true, AFTER_DRAIN = false, MIDK = false;
    bf16_t* O; int ldc;
    __device__ __forceinline__ void operator()(const f32x4 (&acc)[2][2][4][2], const Unit& u, int wr, int wc, int fr, int fq) const {
        const int row0 = u.pm * BM + wr * 64 + fr, col0 = u.pn * BM + wc * 32 + 8 * fq;
#pragma unroll
        for (int ai = 0; ai < 2; ++ai)
#pragma unroll
            for (int m = 0; m < 4; ++m) { bf16_t* rowp = O + (size_t)(row0 + ai * HALF + m * 16) * ldc + col0;
#pragma unroll
                for (int bj = 0; bj < 2; ++bj) { const f32x4 v0 = acc[ai][bj][m][0], v1 = acc[ai][bj][m][1];
                    u32x4 w; w.x = cvt_pk_bf16(v0[0], v0[1]); w.y = cvt_pk_bf16(v0[2], v0[3]); w.z = cvt_pk_bf16(v1[0], v1[1]); w.w = cvt_pk_bf16(v1[2], v1[3]);
                    *(u32x4*)(rowp + bj * HALF) = w; } }
    }
};
struct EpiF32P {
    static constexpr bool PERM = false, AFTER_DRAIN = false, MIDK = false;
    float* C; int ldc;
    __device__ __forceinline__ void operator()(const f32x4 (&acc)[2][2][4][2], const Unit& u, int wr, int wc, int fr, int fq) const {
        const int row0 = u.pm * BM + wr * 64 + fr, col0 = u.pn * BM + wc * 32 + 4 * fq;
#pragma unroll
        for (int ai = 0; ai < 2; ++ai)
#pragma unroll
            for (int m = 0; m < 4; ++m) { float* rowp = C + (size_t)(row0 + ai * HALF + m * 16) * ldc + col0;
#pragma unroll
                for (int bj = 0; bj < 2; ++bj)
#pragma unroll
                    for (int n = 0; n < 2; ++n) *(f32x4*)(rowp + bj * HALF + n * 16) = acc[ai][bj][m][n]; }
    }
};
struct EpiBf16Gate {
    static constexpr bool PERM = true, AFTER_DRAIN = false, MIDK = false;
    bf16_t* O; int ldc; int gate_tile0;
    __device__ __forceinline__ void operator()(const f32x4 (&acc)[2][2][4][2], const Unit& u, int wr, int wc, int fr, int fq) const {
        const int row0 = u.pm * BM + wr * 64 + fr, col0 = u.pn * BM + wc * 32 + 8 * fq; const bool gate = u.pn >= gate_tile0;
#pragma unroll
        for (int ai = 0; ai < 2; ++ai)
#pragma unroll
            for (int m = 0; m < 4; ++m) { bf16_t* rowp = O + (size_t)(row0 + ai * HALF + m * 16) * ldc + col0;
#pragma unroll
                for (int bj = 0; bj < 2; ++bj) { f32x4 v0 = acc[ai][bj][m][0], v1 = acc[ai][bj][m][1];
                    if (gate) {
#pragma unroll
                        for (int e = 0; e < 4; ++e) { v0[e] = fmaxf(sigmoid_f(v0[e]), 1e-12f); v1[e] = fmaxf(sigmoid_f(v1[e]), 1e-12f); } }
                    u32x4 w; w.x = cvt_pk_bf16(v0[0], v0[1]); w.y = cvt_pk_bf16(v0[2], v0[3]); w.z = cvt_pk_bf16(v1[0], v1[1]); w.w = cvt_pk_bf16(v1[2], v1[3]);
                    *(u32x4*)(rowp + bj * HALF) = w; } }
    }
};
struct EpiMergeK {
    static constexpr bool PERM = true, AFTER_DRAIN = false, MIDK = true;
    static constexpr int KB0 = 16, KB1 = 24;
    const bf16_t* gate; int ldg;
    bf16_t* O; int ldc;
    __device__ __forceinline__ void midk(f32x4 (&acc)[2][2][4][2], const Unit& u, int b, int wr, int wc, int fr, int fq) const {
        const int row0 = u.pm * BM + wr * 64 + fr, col0 = u.pn * BM + wc * 32 + 8 * fq;
#pragma unroll
        for (int ai = 0; ai < 2; ++ai) {
            u32x4 ga[4][2], gb[4][2];
#pragma unroll
            for (int m = 0; m < 4; ++m)
#pragma unroll
                for (int bj = 0; bj < 2; ++bj) { const bf16_t* gp = gate + (size_t)(row0 + ai * HALF + m * 16) * ldg + b * 2048 + col0 + bj * HALF; ga[m][bj] = *(const u32x4*)gp; gb[m][bj] = *(const u32x4*)(gp + 2048); }
#pragma unroll
            for (int m = 0; m < 4; ++m)
#pragma unroll
                for (int bj = 0; bj < 2; ++bj) { const u32x4 x = ga[m][bj], y = gb[m][bj];
                    acc[ai][bj][m][0][0] *= bf_lo(x.x) * __builtin_amdgcn_rcpf(bf_lo(y.x)); acc[ai][bj][m][0][1] *= bf_hi(x.x) * __builtin_amdgcn_rcpf(bf_hi(y.x));
                    acc[ai][bj][m][0][2] *= bf_lo(x.y) * __builtin_amdgcn_rcpf(bf_lo(y.y)); acc[ai][bj][m][0][3] *= bf_hi(x.y) * __builtin_amdgcn_rcpf(bf_hi(y.y));
                    acc[ai][bj][m][1][0] *= bf_lo(x.z) * __builtin_amdgcn_rcpf(bf_lo(y.z)); acc[ai][bj][m][1][1] *= bf_hi(x.z) * __builtin_amdgcn_rcpf(bf_hi(y.z));
                    acc[ai][bj][m][1][2] *= bf_lo(x.w) * __builtin_amdgcn_rcpf(bf_lo(y.w)); acc[ai][bj][m][1][3] *= bf_hi(x.w) * __builtin_amdgcn_rcpf(bf_hi(y.w)); }
        }
    }
    __device__ __forceinline__ void operator()(const f32x4 (&acc)[2][2][4][2], const Unit& u, int wr, int wc, int fr, int fq) const {
        const int row0 = u.pm * BM + wr * 64 + fr, col0 = u.pn * BM + wc * 32 + 8 * fq;
#pragma unroll
        for (int ai = 0; ai < 2; ++ai)
#pragma unroll
            for (int m = 0; m < 4; ++m) { const size_t row = (size_t)(row0 + ai * HALF + m * 16);
#pragma unroll
                for (int bj = 0; bj < 2; ++bj) { const f32x4 v0 = acc[ai][bj][m][0], v1 = acc[ai][bj][m][1];
                    const u32x4 g = *(const u32x4*)(gate + row * ldg + 2 * 2048 + col0 + bj * HALF);
                    u32x4 w; w.x = cvt_pk_bf16(v0[0] * bf_lo(g.x), v0[1] * bf_hi(g.x)); w.y = cvt_pk_bf16(v0[2] * bf_lo(g.y), v0[3] * bf_hi(g.y));
                    w.z = cvt_pk_bf16(v1[0] * bf_lo(g.z), v1[1] * bf_hi(g.z)); w.w = cvt_pk_bf16(v1[2] * bf_lo(g.w), v1[3] * bf_hi(g.w));
                    *(u32x4*)(O + row * ldc + col0 + bj * HALF) = w; } }
    }
};
typedef _Float16 h4v_t __attribute__((ext_vector_type(4)));
struct EpiF32Slab {
    static constexpr bool PERM = false, AFTER_DRAIN = false, MIDK = false;
    _Float16* C; int ldc; size_t slab;
    __device__ __forceinline__ void operator()(const f32x4 (&acc)[2][2][4][2], const Unit& u, int wr, int wc, int fr, int fq) const {
        const int row0 = u.pm * BM + wr * 64 + fr, col0 = u.pn * BM + wc * 32 + 4 * fq;
        _Float16* base = C + (size_t)u.ks * slab;
#pragma unroll
        for (int ai = 0; ai < 2; ++ai)
#pragma unroll
            for (int m = 0; m < 4; ++m) { _Float16* rowp = base + (size_t)(row0 + ai * HALF + m * 16) * ldc + col0;
#pragma unroll
                for (int bj = 0; bj < 2; ++bj)
#pragma unroll
                    for (int n = 0; n < 2; ++n) { const f32x4 a = acc[ai][bj][m][n]; h4v_t h; h.x = (_Float16)a[0]; h.y = (_Float16)a[1]; h.z = (_Float16)a[2]; h.w = (_Float16)a[3]; *(h4v_t*)(rowp + bj * HALF + n * 16) = h; } }
    }
};
struct EpiAct {
    static constexpr bool PERM = true, AFTER_DRAIN = true, MIDK = false;
    bf16_t* ACT; int dff;
    const float* cw; const float* cb;
    float* HP; float* HU; float* HA;
    __device__ __forceinline__ void refuse(size_t, size_t, int, int) const {}
    __device__ __forceinline__ void fused(f32x4 (&acc)[2][2][4][2], const Unit& u, int wr, int wc, int fr, int fq, PG8_LAS unsigned char* lds, int wid, int lane) const {
        const int cl = wc * 32 + 8 * fq;
        const int j0 = u.pn * 128 + cl;
#pragma unroll
        for (int ai = 0; ai < 2; ++ai)
#pragma unroll
            for (int m = 0; m < 4; ++m) { const int r = ai * HALF + wr * 64 + m * 16 + fr; const f32x4 v0 = acc[ai][0][m][0], v1 = acc[ai][0][m][1];
                u32x4 w; w.x = cvt_pk_bf16(v0[0], v0[1]); w.y = cvt_pk_bf16(v0[2], v0[3]); w.z = cvt_pk_bf16(v1[0], v1[1]); w.w = cvt_pk_bf16(v1[2], v1[3]);
                *(PG8_LAS u32x4*)(lds + r * 272 + cl * 2) = w; }
        float w0[8], w1[8], w2[8], bb[8];
#pragma unroll
        for (int q = 0; q < 2; ++q) { const f32x4 a = *(const f32x4*)(cw + j0 + 4 * q), b = *(const f32x4*)(cw + dff + j0 + 4 * q), c = *(const f32x4*)(cw + 2 * dff + j0 + 4 * q), d = *(const f32x4*)(cb + j0 + 4 * q);
#pragma unroll
            for (int e = 0; e < 4; ++e) { w0[4 * q + e] = a[e]; w1[4 * q + e] = b[e]; w2[4 * q + e] = c[e]; bb[4 * q + e] = d[e]; } }
        asm volatile("s_waitcnt lgkmcnt(0)" ::: "memory"); __builtin_amdgcn_s_barrier(); asm volatile("" ::: "memory");
        const int t0 = u.pm * BM;
        const int seqlen = t0 < 16384 ? 4096 : 256;
        const bool top_open = (t0 % seqlen) != 0, bot_open = ((t0 + BM) % seqlen) != 0;
#pragma unroll
        for (int ai = 0; ai < 2; ++ai)
#pragma unroll
            for (int m = 0; m < 4; ++m) { const int r = ai * HALF + wr * 64 + m * 16 + fr;
                const u32x4 zero = {0u, 0u, 0u, 0u};
                const u32x4 pv = r > 0 ? *(const PG8_LAS u32x4*)(lds + (r - 1) * 272 + cl * 2) : zero;
                const u32x4 nx = r < BM - 1 ? *(const PG8_LAS u32x4*)(lds + (r + 1) * 272 + cl * 2) : zero;
                const f32x4 a0 = acc[ai][0][m][0], a1 = acc[ai][0][m][1], u0 = acc[ai][1][m][0], u1 = acc[ai][1][m][1];
                const float ac[8] = {a0[0], a0[1], a0[2], a0[3], a1[0], a1[1], a1[2], a1[3]}, uc[8] = {u0[0], u0[1], u0[2], u0[3], u1[0], u1[1], u1[2], u1[3]};
                const float pf[8] = {bf_lo(pv.x), bf_hi(pv.x), bf_lo(pv.y), bf_hi(pv.y), bf_lo(pv.z), bf_hi(pv.z), bf_lo(pv.w), bf_hi(pv.w)};
                const float nf[8] = {bf_lo(nx.x), bf_hi(nx.x), bf_lo(nx.y), bf_hi(nx.y), bf_lo(nx.z), bf_hi(nx.z), bf_lo(nx.w), bf_hi(nx.w)};
                float pre[8], res[8];
#pragma unroll
                for (int e = 0; e < 8; ++e) { pre[e] = w0[e] * pf[e] + w1[e] * ac[e] + w2[e] * nf[e] + bb[e]; res[e] = pre[e] * sigmoid_f(pre[e]) * uc[e]; }
                const bool edge0 = (r == 0), edge1 = (r == BM - 1);
                if (edge0 || edge1) {
                    const size_t ho = ((size_t)u.pm * 2 + (edge1 ? 1 : 0)) * dff + j0;
#pragma unroll
                    for (int q = 0; q < 2; ++q) { *(f32x4*)(HA + ho + 4 * q) = (f32x4){ac[4 * q], ac[4 * q + 1], ac[4 * q + 2], ac[4 * q + 3]};
                        *(f32x4*)(HP + ho + 4 * q) = (f32x4){pre[4 * q], pre[4 * q + 1], pre[4 * q + 2], pre[4 * q + 3]}; *(f32x4*)(HU + ho + 4 * q) = (f32x4){uc[4 * q], uc[4 * q + 1], uc[4 * q + 2], uc[4 * q + 3]}; }
                }
                if (!((edge0 && top_open) || (edge1 && bot_open))) {
                    u32x4 w; w.x = cvt_pk_bf16(res[0], res[1]); w.y = cvt_pk_bf16(res[2], res[3]); w.z = cvt_pk_bf16(res[4], res[5]); w.w = cvt_pk_bf16(res[6], res[7]);
                    *(u32x4*)(ACT + (size_t)(t0 + r) * dff + j0) = w; }
            }
    }
};
template <class Epi, class Sched, bool ALIGN_EPI = false, bool SP2 = false>
__device__ __forceinline__ void gemm_phase(PG8_LAS unsigned char* lds, const Gemm g, const Sched& S, const Epi& E, int tid_in) {
    int tid_ = tid_in; asm volatile("" : "+v"(tid_));
    const int tid = tid_, wid = __builtin_amdgcn_readfirstlane(tid >> 6), lane = tid & 63, wr = wid >> 2, wc = wid & 3, fr = lane & 15, fq = lane >> 4;
    const int K = g.K, nt = K / BK;
    unsigned voffA[2], voffB[2];
#pragma unroll
    for (int i = 0; i < 2; ++i) { int R, C; stage_rc(tid * 16 + i * 8192, R, C); const int Rb = Epi::PERM ? ((R & ~31) + perm32(R & 31)) : R;
        voffA[i] = (unsigned)(R * g.lda + C) * 2u; voffB[i] = (unsigned)(Rb * g.ldb + C) * 2u; }
    const size_t kstep = (size_t)(BK * 2);
    const size_t hstepA = (size_t)HALF * g.lda * 2, hstepB = (size_t)HALF * g.ldb * 2;
    const size_t tstepA = 2 * hstepA, tstepB = 2 * hstepB;
    const size_t sstep = (size_t)K * 2;
    const unsigned ldsw = (unsigned)wid * 1024u;
    const int aoff = lds_byte(wr * 64 + fr, fq * 8), boff = lds_byte(wc * 32 + fr, fq * 8);
#define PG8_SA(b, h) (((b) * 2 + (h)) * HTB)
#define PG8_SB(b, h) ((4 + (b) * 2 + (h)) * HTB)
#define PG8_STAGE(bufoff, gbase, voff) do { _Pragma("unroll") for (int _i = 0; _i < 2; ++_i) \
        __builtin_amdgcn_global_load_lds((const unsigned*)((const char*)(gbase) + (voff)[_i]), (PG8_LAS unsigned*)(lds + (bufoff) + ldsw + _i * 8192), 16, 0, 0); } while (0)
#define PG8_LDA(dst, b, h) do { _Pragma("unroll") for (int m = 0; m < 4; ++m) _Pragma("unroll") for (int k = 0; k < 2; ++k) dst[m][k] = *(const PG8_LAS bf16x8*)(lds + PG8_SA(b, h) + aoff + m * 2048 + k * 1024); } while (0)
#define PG8_LDB(dst, b, h) do { _Pragma("unroll") for (int n = 0; n < 2; ++n) _Pragma("unroll") for (int k = 0; k < 2; ++k) dst[n][k] = *(const PG8_LAS bf16x8*)(lds + PG8_SB(b, h) + boff + n * 2048 + k * 1024); } while (0)
#define PG8_MMA(ai, bj, At, Bt) do { __builtin_amdgcn_s_setprio(1); _Pragma("unroll") for (int m = 0; m < 4; ++m) _Pragma("unroll") for (int n = 0; n < 2; ++n) _Pragma("unroll") for (int k = 0; k < 2; ++k) \
        acc[ai][bj][m][n] = __builtin_amdgcn_mfma_f32_16x16x32_bf16(Bt[n][k], At[m][k], acc[ai][bj][m][n], 0, 0, 0); __builtin_amdgcn_s_setprio(0); } while (0)
#define PG8_WAIT_V(n) asm volatile("s_waitcnt vmcnt(" #n ")" ::: "memory")
#define PG8_WAIT_L(n) asm volatile("s_waitcnt lgkmcnt(" #n ")" ::: "memory")
#define PG8_BAR __builtin_amdgcn_s_barrier()
#define PG8_SCHED __builtin_amdgcn_sched_barrier(0)
    Unit cur, nxt; int ui = 0;
    if (!S.next(0, cur)) return;
    f32x4 acc[2][2][4][2];
#pragma unroll
    for (int a = 0; a < 2; ++a)
#pragma unroll
        for (int b = 0; b < 2; ++b)
#pragma unroll
            for (int m = 0; m < 4; ++m)
#pragma unroll
                for (int n = 0; n < 2; ++n) acc[a][b][m][n] = (f32x4){0.f, 0.f, 0.f, 0.f};
    bf16x8 At[4][2], B0[2][2], B1[2][2];
    const char* cA = (const char*)g.A + (size_t)cur.pm * tstepA + (size_t)cur.ks * sstep; const char* cB = (const char*)g.Bt + (size_t)cur.pn * tstepB + (size_t)cur.ks * sstep;
    S.a_ready(cur);
    if constexpr (SP2) {
        PG8_STAGE(PG8_SB(0, 0), cB, voffB); PG8_STAGE(PG8_SB(0, 1), cB + hstepB, voffB); PG8_STAGE(PG8_SA(0, 0), cA, voffA); PG8_STAGE(PG8_SA(0, 1), cA + hstepA, voffA);
        if (wr == 1) PG8_BAR;
        PG8_WAIT_V(2); PG8_BAR;
        PG8_STAGE(PG8_SB(1, 0), cB + kstep, voffB); PG8_STAGE(PG8_SA(1, 0), cA + kstep, voffA); PG8_STAGE(PG8_SB(1, 1), cB + hstepB + kstep, voffB);
        PG8_WAIT_V(6); PG8_BAR;
    } else {
        PG8_STAGE(PG8_SB(0, 0), cB, voffB); PG8_STAGE(PG8_SA(0, 0), cA, voffA); PG8_STAGE(PG8_SB(0, 1), cB + hstepB, voffB); PG8_STAGE(PG8_SA(0, 1), cA + hstepA, voffA);
        if (wr == 1) PG8_BAR;
        PG8_WAIT_V(4); PG8_BAR;
        PG8_STAGE(PG8_SB(1, 0), cB + kstep, voffB); PG8_STAGE(PG8_SA(1, 0), cA + kstep, voffA); PG8_STAGE(PG8_SB(1, 1), cB + hstepB + kstep, voffB);
        PG8_WAIT_V(6); PG8_BAR;
    }
    for (;;) {
        const bool has_next = S.next(ui + 1, nxt);
        const char* nA = has_next ? (const char*)g.A + (size_t)nxt.pm * tstepA + (size_t)nxt.ks * sstep : cA; const char* nB = has_next ? (const char*)g.Bt + (size_t)nxt.pn * tstepB + (size_t)nxt.ks * sstep : cB;
        for (int t = 0; t < nt; t += 2) {
            if constexpr (Epi::MIDK) { if (t == Epi::KB0) E.midk(acc, cur, 0, wr, wc, fr, fq); else if (t == Epi::KB1) E.midk(acc, cur, 1, wr, wc, fr, fq); }
            const bool last = (t == nt - 2);
            const char* a1 = cA + (size_t)(t + 1) * kstep;
            const char* a2 = last ? nA : cA + (size_t)(t + 2) * kstep; const char* b2 = last ? nB : cB + (size_t)(t + 2) * kstep;
            const char* a3 = a2 + kstep; const char* b3 = b2 + kstep;
            if (last && has_next) S.a_ready(nxt);
            if constexpr (SP2) {
            PG8_LDB(B0, 0, 0); PG8_LDB(B1, 0, 1); PG8_SCHED; PG8_LDA(At, 0, 0); PG8_STAGE(PG8_SA(1, 1), a1 + hstepA, voffA);
            PG8_WAIT_V(8); PG8_WAIT_L(0); PG8_BAR; PG8_MMA(0, 0, At, B0); PG8_MMA(0, 1, At, B1); PG8_BAR; PG8_SCHED;
            PG8_LDA(At, 0, 1); PG8_STAGE(PG8_SB(0, 0), b2, voffB); PG8_STAGE(PG8_SB(0, 1), b2 + hstepB, voffB); PG8_STAGE(PG8_SA(0, 0), a2, voffA);
            PG8_WAIT_V(8); PG8_WAIT_L(0); PG8_BAR; PG8_MMA(1, 0, At, B0); PG8_MMA(1, 1, At, B1); PG8_BAR; PG8_SCHED;
            PG8_LDB(B0, 1, 0); PG8_LDB(B1, 1, 1); PG8_SCHED; PG8_LDA(At, 1, 0); PG8_STAGE(PG8_SA(0, 1), a2 + hstepA, voffA);
            PG8_WAIT_V(8); PG8_WAIT_L(0); PG8_BAR; PG8_MMA(0, 0, At, B0); PG8_MMA(0, 1, At, B1); PG8_BAR; PG8_SCHED;
            PG8_LDA(At, 1, 1); PG8_STAGE(PG8_SB(1, 0), b3, voffB); PG8_STAGE(PG8_SB(1, 1), b3 + hstepB, voffB); PG8_STAGE(PG8_SA(1, 0), a3, voffA);
            PG8_WAIT_V(8); PG8_WAIT_L(0); PG8_BAR; PG8_MMA(1, 0, At, B0); PG8_MMA(1, 1, At, B1); PG8_BAR; PG8_SCHED;
            } else {
            PG8_LDB(B0, 0, 0); PG8_SCHED; PG8_LDA(At, 0, 0); PG8_STAGE(PG8_SA(1, 1), a1 + hstepA, voffA);
            PG8_WAIT_L(8); PG8_BAR; PG8_WAIT_L(0); PG8_MMA(0, 0, At, B0); PG8_BAR; PG8_SCHED;
            PG8_LDB(B1, 0, 1); PG8_STAGE(PG8_SB(0, 0), b2, voffB);
            PG8_BAR; PG8_WAIT_L(0); PG8_MMA(0, 1, At, B1); PG8_BAR;
            PG8_LDA(At, 0, 1); PG8_STAGE(PG8_SA(0, 0), a2, voffA);
            PG8_BAR; PG8_WAIT_L(0); PG8_MMA(1, 0, At, B0); PG8_BAR; PG8_SCHED;
            PG8_STAGE(PG8_SB(0, 1), b2 + hstepB, voffB);
            PG8_WAIT_V(6); PG8_BAR; PG8_MMA(1, 1, At, B1); PG8_BAR;
            PG8_LDB(B0, 1, 0); PG8_SCHED; PG8_LDA(At, 1, 0); PG8_STAGE(PG8_SA(0, 1), a2 + hstepA, voffA);
            PG8_WAIT_L(8); PG8_BAR; PG8_WAIT_L(0); PG8_MMA(0, 0, At, B0); PG8_BAR; PG8_SCHED;
            PG8_LDB(B1, 1, 1); PG8_STAGE(PG8_SB(1, 0), b3, voffB);
            PG8_BAR; PG8_WAIT_L(0); PG8_MMA(0, 1, At, B1); PG8_BAR;
            PG8_LDA(At, 1, 1); PG8_STAGE(PG8_SA(1, 0), a3, voffA);
            PG8_BAR; PG8_WAIT_L(0); PG8_MMA(1, 0, At, B0); PG8_BAR; PG8_SCHED;
            PG8_STAGE(PG8_SB(1, 1), b3 + hstepB, voffB);
            PG8_WAIT_V(6); PG8_BAR; PG8_MMA(1, 1, At, B1); PG8_BAR;
            }
        }
        if constexpr (ALIGN_EPI) { if (wr == 0) PG8_BAR; }
        if constexpr (!Epi::AFTER_DRAIN) { E(acc, cur, wr, wc, fr, fq); S.done(cur); }
        if (!has_next) break;
#pragma unroll
        for (int a = 0; a < 2; ++a)
#pragma unroll
            for (int b = 0; b < 2; ++b)
#pragma unroll
                for (int m = 0; m < 4; ++m)
#pragma unroll
                    for (int n = 0; n < 2; ++n) acc[a][b][m][n] = (f32x4){0.f, 0.f, 0.f, 0.f};
        cur = nxt; cA = nA; cB = nB; ++ui;
        if constexpr (ALIGN_EPI) { if (wr == 1) PG8_BAR; }
    }
    PG8_WAIT_V(0);
    if constexpr (!ALIGN_EPI) { if (wr == 0) PG8_BAR; }
    PG8_BAR;
    if constexpr (Epi::AFTER_DRAIN) { E.fused(acc, cur, wr, wc, fr, fq, lds, wid, lane); S.done(cur); }
#undef PG8_SA
#undef PG8_SB
#undef PG8_STAGE
#undef PG8_LDA
#undef PG8_LDB
#undef PG8_MMA
#undef PG8_WAIT_V
#undef PG8_WAIT_L
#undef PG8_BAR
#undef PG8_SCHED
}
}
#define HD __host__ __device__ __forceinline__
#if defined(__HIP_DEVICE_COMPILE__)
#define FFT_PIN() __builtin_amdgcn_sched_barrier(0)
#else
#define FFT_PIN() ((void)0)
#endif
typedef float cf2 __attribute__((ext_vector_type(2)));
HD cf2 cmul(cf2 a, cf2 b) { const cf2 b2 = {-b.y, b.x}; return a.xx * b + a.yy * b2; }
HD constexpr int PADI(int i) { return i + (i >> 5); }
constexpr int FFT_N = 8192, FFT_PADN = 8448;
HD constexpr float c32tab(int k) {
    constexpr float t[16] = {1.0f, 0.98078528040323043f, 0.92387953251128674f, 0.83146961230254524f, 0.70710678118654752f, 0.55557023301960218f, 0.38268343236508977f, 0.19509032201612825f,
                             0.0f, -0.19509032201612825f, -0.38268343236508977f, -0.55557023301960218f, -0.70710678118654752f, -0.83146961230254524f, -0.92387953251128674f, -0.98078528040323043f};
    return t[k];
}
HD constexpr float s32tab(int k) {
    constexpr float t[16] = {0.0f, 0.19509032201612825f, 0.38268343236508977f, 0.55557023301960218f, 0.70710678118654752f, 0.83146961230254524f, 0.92387953251128674f, 0.98078528040323043f,
                             1.0f, 0.98078528040323043f, 0.92387953251128674f, 0.83146961230254524f, 0.70710678118654752f, 0.55557023301960218f, 0.38268343236508977f, 0.19509032201612825f};
    return t[k];
}
HD constexpr int bitrev_c(int x, int bits) { int r = 0; for (int b = 0; b < bits; ++b) r |= ((x >> b) & 1) << (bits - 1 - b); return r; }
template <int R, int LOGR, int SIGN> HD void dft_reg(cf2 (&v)[R]) {
#pragma unroll
    for (int ls = LOGR - 1; ls >= 0; --ls) {
        const int span = 1 << ls;
#pragma unroll
        for (int i = 0; i < R; ++i) {
            if ((i & span) == 0) {
                const int k32 = (i & (span - 1)) * (R / (2 * span)) * (32 / R);
                const cf2 a = v[i], b = v[i + span]; v[i] = a + b; const cf2 d = a - b;
                if (k32 == 0) v[i + span] = d;
                else if (k32 == 8) { const cf2 m = {-(float)SIGN, (float)SIGN}; v[i + span] = d.yx * m; }
                else { const cf2 w1 = {c32tab(k32), (float)SIGN * s32tab(k32)}, w2 = {-(float)SIGN * s32tab(k32), c32tab(k32)}; v[i + span] = d.xx * w1 + d.yy * w2; }
            }
        }
    }
}
template <int R, int LOGR, int PM, bool TW> HD void fft_fwd_group(cf2* Xp, cf2 w) {
    cf2 v[R];
#pragma unroll
    for (int q = 0; q < R; ++q) v[q] = Xp[PM * q];
    dft_reg<R, LOGR, -1>(v);
    cf2 wp = {1.f, 0.f};
#pragma unroll
    for (int q = 0; q < R; ++q) { cf2 y = v[bitrev_c(q, LOGR)];
        if (TW && q > 0) { wp = cmul(wp, w); y = cmul(y, wp); }
        Xp[PM * q] = y; }
}
template <int R, int LOGR, int PM, bool TW> HD void fft_inv_group(cf2* Xp, cf2 w) {
    cf2 v[R];
    const cf2 wc = {w.x, -w.y}; cf2 wp = {1.f, 0.f};
#pragma unroll
    for (int q = 0; q < R; ++q) v[q] = Xp[PM * q];
    FFT_PIN();
#pragma unroll
    for (int q = 1; q < R; ++q) if (TW) { wp = cmul(wp, wc); v[q] = cmul(v[q], wp); }
    dft_reg<R, LOGR, +1>(v);
#pragma unroll
    for (int q = 0; q < R; ++q) Xp[PM * q] = v[bitrev_c(q, LOGR)];
}
HD int fft_pos_to_k(int p) { return (p >> 9) + 16 * ((p >> 5) & 15) + 256 * (p & 31); }
HD int fft_k_to_pos(int k) { return 512 * (k & 15) + 32 * ((k >> 4) & 15) + (k >> 8); }
HD int fft_conj_pos(int p) { return fft_k_to_pos((FFT_N - fft_pos_to_k(p)) & (FFT_N - 1)); }
HD void fft_fwd_passA(cf2* X, const cf2* TWL, int tid) { fft_fwd_group<16, 4, 528, true>(X + PADI(tid), TWL[tid]); }
HD void fft_fwd_passB(cf2* X, const cf2* TWL, int tid) { const int blk = tid >> 5, j = tid & 31; fft_fwd_group<16, 4, 33, true>(X + 528 * blk + j, TWL[16 * j]); }
HD void fft_fwd_passC(cf2* X, int g) { const cf2 w = {1.f, 0.f}; fft_fwd_group<32, 5, 1, false>(X + 33 * g, w); }
HD void fft_inv_passC(cf2* X, int g) { const cf2 w = {1.f, 0.f}; fft_inv_group<32, 5, 1, false>(X + 33 * g, w); }
HD void fft_inv_passB(cf2* X, const cf2* TWL, int tid) { const int blk = tid >> 5, j = tid & 31; fft_inv_group<16, 4, 33, true>(X + 528 * blk + j, TWL[16 * j]); }
HD void fft_inv_passA(cf2* X, const cf2* TWL, int tid) { fft_inv_group<16, 4, 528, true>(X + PADI(tid), TWL[tid]); }
template <class KP> HD void fft_passC_conv_half(cf2* X, const cf2 (&kk)[16], KP K, int g) {
    cf2* Xp = X + 33 * g; cf2 v[32], w[32];
#pragma unroll
    for (int q = 0; q < 32; ++q) v[q] = Xp[q];
    dft_reg<32, 5, -1>(v);
#pragma unroll
    for (int q = 0; q < 16; ++q) w[q] = cmul(v[bitrev_c(q, 5)], kk[q]);
#pragma unroll
    for (int q = 16; q < 32; ++q) { const cf2 k = {K[32 * g + q].x, K[32 * g + q].y}; w[q] = cmul(v[bitrev_c(q, 5)], k); }
    dft_reg<32, 5, +1>(w);
#pragma unroll
    for (int q = 0; q < 32; ++q) Xp[q] = w[bitrev_c(q, 5)];
}
HD void fft_passC_conv_regs(cf2* X, const cf2 (&kk)[32], int g) {
    cf2* Xp = X + 33 * g; cf2 v[32], w[32];
#pragma unroll
    for (int q = 0; q < 32; ++q) v[q] = Xp[q];
    dft_reg<32, 5, -1>(v);
#pragma unroll
    for (int q = 0; q < 32; ++q) w[q] = cmul(v[bitrev_c(q, 5)], kk[q]);
    dft_reg<32, 5, +1>(w);
#pragma unroll
    for (int q = 0; q < 32; ++q) Xp[q] = w[bitrev_c(q, 5)];
}
template <class KP> HD void fft_passC_conv(cf2* X, KP K, int g) {
    cf2* Xp = X + 33 * g; cf2 v[32], w[32];
#pragma unroll
    for (int q = 0; q < 32; ++q) v[q] = Xp[q];
    dft_reg<32, 5, -1>(v);
#pragma unroll
    for (int q = 0; q < 32; ++q) { const cf2 k = {K[32 * g + q].x, K[32 * g + q].y}; w[q] = cmul(v[bitrev_c(q, 5)], k); }
    dft_reg<32, 5, +1>(w);
#pragma unroll
    for (int q = 0; q < 32; ++q) Xp[q] = w[bitrev_c(q, 5)];
}
HD void fft_fwd_passA_zp(cf2* X, const cf2* TWL, int tid) {
    cf2* Xp = X + PADI(tid); cf2 v[16];
#pragma unroll
    for (int q = 0; q < 8; ++q) v[q] = Xp[528 * q];
#pragma unroll
    for (int q = 8; q < 16; ++q) { v[q].x = 0.f; v[q].y = 0.f; }
    dft_reg<16, 4, -1>(v);
    const cf2 w = TWL[tid]; cf2 wp = {1.f, 0.f};
#pragma unroll
    for (int q = 0; q < 16; ++q) { cf2 y = v[bitrev_c(q, 4)]; if (q > 0) { wp = cmul(wp, w); y = cmul(y, wp); } Xp[528 * q] = y; }
}
HD void fft_inv_passA_half(cf2* X, const cf2* TWL, int tid) {
    cf2* Xp = X + PADI(tid); cf2 v[16];
    const cf2 w = TWL[tid]; const cf2 wc = {w.x, -w.y}; cf2 wp = {1.f, 0.f};
#pragma unroll
    for (int q = 0; q < 16; ++q) v[q] = Xp[528 * q];
    FFT_PIN();
#pragma unroll
    for (int q = 1; q < 16; ++q) { wp = cmul(wp, wc); v[q] = cmul(v[q], wp); }
    dft_reg<16, 4, +1>(v);
#pragma unroll
    for (int q = 0; q < 8; ++q) Xp[528 * q] = v[bitrev_c(q, 4)];
}

template <int R, int LOGR, int PM, bool TW, int NLOAD> HD void fft_fwd_group2(cf2* Xp0, cf2* Xp1, cf2 w) {
    cf2 a[R], b[R];
#pragma unroll
    for (int q = 0; q < R; ++q) { if (q < NLOAD) { a[q] = Xp0[PM * q]; b[q] = Xp1[PM * q]; } else { a[q].x = 0.f; a[q].y = 0.f; b[q].x = 0.f; b[q].y = 0.f; } }
    FFT_PIN();
    dft_reg<R, LOGR, -1>(a); dft_reg<R, LOGR, -1>(b);
    cf2 wp = {1.f, 0.f};
#pragma unroll
    for (int q = 0; q < R; ++q) { cf2 ya = a[bitrev_c(q, LOGR)], yb = b[bitrev_c(q, LOGR)];
        if (TW && q > 0) { wp = cmul(wp, w); ya = cmul(ya, wp); yb = cmul(yb, wp); }
        Xp0[PM * q] = ya; Xp1[PM * q] = yb; }
}
template <int R, int LOGR, int PM, bool TW, int NSTORE> HD void fft_inv_group2(cf2* Xp0, cf2* Xp1, cf2 w) {
    cf2 a[R], b[R];
#pragma unroll
    for (int q = 0; q < R; ++q) { a[q] = Xp0[PM * q]; b[q] = Xp1[PM * q]; }
    FFT_PIN();
    const cf2 wc = {w.x, -w.y}; cf2 wp = {1.f, 0.f};
#pragma unroll
    for (int q = 1; q < R; ++q) if (TW) { wp = cmul(wp, wc); a[q] = cmul(a[q], wp); b[q] = cmul(b[q], wp); }
    dft_reg<R, LOGR, +1>(a); dft_reg<R, LOGR, +1>(b);
#pragma unroll
    for (int q = 0; q < NSTORE; ++q) { Xp0[PM * q] = a[bitrev_c(q, LOGR)]; Xp1[PM * q] = b[bitrev_c(q, LOGR)]; }
}
HD void fft_fwd_passA2(cf2* X0, cf2* X1, const cf2* TWL, int tid) { fft_fwd_group2<16, 4, 528, true, 16>(X0 + PADI(tid), X1 + PADI(tid), TWL[tid]); }
HD void fft_fwd_passA2_zp(cf2* X0, cf2* X1, const cf2* TWL, int tid) { fft_fwd_group2<16, 4, 528, true, 8>(X0 + PADI(tid), X1 + PADI(tid), TWL[tid]); }
HD void fft_fwd_passB2(cf2* X0, cf2* X1, const cf2* TWL, int tid) { const int blk = tid >> 5, j = tid & 31; fft_fwd_group2<16, 4, 33, true, 16>(X0 + 528 * blk + j, X1 + 528 * blk + j, TWL[16 * j]); }
HD void fft_inv_passB2(cf2* X0, cf2* X1, const cf2* TWL, int tid) { const int blk = tid >> 5, j = tid & 31; fft_inv_group2<16, 4, 33, true, 16>(X0 + 528 * blk + j, X1 + 528 * blk + j, TWL[16 * j]); }
HD void fft_inv_passA2(cf2* X0, cf2* X1, const cf2* TWL, int tid) { fft_inv_group2<16, 4, 528, true, 16>(X0 + PADI(tid), X1 + PADI(tid), TWL[tid]); }
HD void fft_inv_passA2_half(cf2* X0, cf2* X1, const cf2* TWL, int tid) { fft_inv_group2<16, 4, 528, true, 8>(X0 + PADI(tid), X1 + PADI(tid), TWL[tid]); }
constexpr int DM = 2048, NBATCH = 4, SEQ = 4096, DEPTH = 4, CTXL = 256, HDIM = 128;
constexpr int ML = NBATCH * SEQ, MC = NBATCH * CTXL, MT = ML + MC;
constexpr int HYW = 1024, NIN = 11776, DFF = 5632, NMOD = 6 * DM;
constexpr int NP = 7936, NU = 3840;
constexpr int P_NAK = 0, P_SWK = 512, P_NAQ = 768, P_SWQ = 1280, P_GATE = 1792;
constexpr int U_HY = 0, U_NAV = 3072, U_SWV = 3584;
constexpr float NORM_EPS = 1e-6f;
constexpr float HY_MIN_DECAY = -3.0701134573253945f, HY_MAX_DECAY = -15.350567286626973f;
constexpr int NWAVES = 8, NTHR = 512;

constexpr size_t MiB = 1u << 20;
constexpr size_t WS_CTL = 0, CTL_ZERO_BYTES = 64 * 1024;
constexpr size_t WS_MODV = 1 * MiB;
constexpr size_t WS_ROPE = 2 * MiB;
constexpr size_t WS_MODC = 2 * MiB + 64 * 1024;
constexpr size_t WS_A2 = 3 * MiB;
constexpr size_t WS_A2C = 7 * MiB;
constexpr size_t WS_KC = 8 * MiB, KC_BUF = 4 * MiB;
constexpr size_t WS_XC = 16 * MiB;
constexpr size_t WS_KSPEC = 24 * MiB, KSPEC_BUF = 64 * MiB;
constexpr size_t WS_WSET = 280 * MiB, WSET_BYTES = 128 * MiB;
constexpr size_t WO_WIN = 0, WO_WBR = 46 * MiB, WO_WOUT = 54 * MiB, WO_WUP = 62 * MiB, WO_WDN = 106 * MiB;
constexpr size_t WS_H = 536 * MiB;
constexpr size_t WS_MM = WS_H;
constexpr size_t WS_MIX = 604 * MiB;
constexpr size_t WS_Y = WS_MIX; constexpr int Y_NA = 1024, Y_SW = 1536;
constexpr size_t WS_ACT = 740 * MiB;
constexpr size_t WS_T1 = WS_ACT, WS_T2 = WS_ACT + 68 * MiB;
constexpr size_t WS_P = 927 * MiB;
constexpr size_t WS_UT = 1191 * MiB;
constexpr size_t WS_AU = WS_P;
constexpr size_t WS_HALO = 1319 * MiB, HALO_ONE = 4 * MiB;
constexpr size_t WS_XH = 152 * MiB;
constexpr size_t WS_END = 1331 * MiB;
static_assert(WS_P + (size_t)MT * NP * 2 <= WS_UT && WS_UT + (size_t)NU * MT * 2 <= WS_HALO && (size_t)68 * 2 * DFF * 4 <= HALO_ONE, "ws map");
static_assert(WS_KSPEC + 2 * KSPEC_BUF <= WS_XH && WS_XH + (size_t)MT * DM * 2 <= WS_WSET, "ws map 4");
static_assert(WS_ACT + (size_t)MT * DFF * 2 <= WS_P && WS_MIX + (size_t)MT * DM * 4 <= WS_ACT && WS_H + (size_t)MT * DM * 2 <= WS_MIX && WS_WSET + 2 * WSET_BYTES <= WS_H && WS_KSPEC + 2 * KSPEC_BUF <= WS_WSET, "ws map 2");
static_assert(WO_WDN + (size_t)DM * DFF * 2 <= WSET_BYTES && WS_Y + (size_t)MT * DM * 2 <= WS_MIX + (size_t)MT * DM * 4 && WS_T2 + (size_t)MT * DM * 2 <= WS_ACT + (size_t)MT * DFF * 2, "ws map 3");
constexpr int CW_TMO = 0, CW_CODE = 1, CW_BAR = 4096;

constexpr int LDS_BYTES = 147456;
constexpr int MISC_OFF = 143360;
constexpr int FFT_BUF_BYTES = FFT_PADN * 8;
constexpr int LDS_X0 = 0, LDS_X1 = FFT_BUF_BYTES, LDS_TW = 2 * FFT_BUF_BYTES;
constexpr int LDS_SM = LDS_TW + 4096;
static_assert(LDS_SM + 4096 <= MISC_OFF, "LDS map");

#define GAS __attribute__((address_space(1)))
#define LAS __attribute__((address_space(3)))
typedef unsigned short bf16;
typedef unsigned v4u __attribute__((ext_vector_type(4)));
typedef unsigned v2u __attribute__((ext_vector_type(2)));
typedef float f32x4 __attribute__((ext_vector_type(4)));
typedef float f32x2v __attribute__((ext_vector_type(2)));
typedef short bf16x8 __attribute__((ext_vector_type(8)));
typedef GAS unsigned gu32;
#define RLX_AGENT __ATOMIC_RELAXED, __HIP_MEMORY_SCOPE_AGENT
#define LDS_WAIT() asm volatile("s_waitcnt lgkmcnt(0)" ::: "memory")
#define VM_WAIT() asm volatile("s_waitcnt vmcnt(0)" ::: "memory")
__device__ __forceinline__ unsigned f2bf(float f) { unsigned u = __builtin_bit_cast(unsigned, f); return (u + 0x7fffu + ((u >> 16) & 1u)) >> 16; }
__device__ __forceinline__ unsigned pk2(float lo, float hi) { return pg8::cvt_pk_bf16(lo, hi); }
__device__ __forceinline__ float bf2f(bf16 b) { return __uint_as_float(((unsigned)b) << 16); }
__device__ __forceinline__ float blo(unsigned u) { return __uint_as_float(u << 16); }
__device__ __forceinline__ float bhi(unsigned u) { return __uint_as_float(u & 0xffff0000u); }
__device__ __forceinline__ float wave_sum(float v) {
#define WS_DPP(x, ctrl, rmask) __builtin_bit_cast(float, __builtin_amdgcn_update_dpp(0, __builtin_bit_cast(int, (x)), (ctrl), (rmask), 0xf, false))
    v += WS_DPP(v, 0xB1, 0xf);
    v += WS_DPP(v, 0x4E, 0xf);
    v += WS_DPP(v, 0x141, 0xf);
    v += WS_DPP(v, 0x140, 0xf);
    v += WS_DPP(v, 0x142, 0xa);
    v += WS_DPP(v, 0x143, 0xc);
#undef WS_DPP
    return __builtin_bit_cast(float, __builtin_amdgcn_readlane(__builtin_bit_cast(int, v), 63));
}
#define XB_TMO      128
#define XB_XCNT(j)  (256  + 64 * (j))
#define XB_XSUB(j)  (1280 + 64 * (j))
#define XB_XGEN(j)  (2304 + 64 * (j))
#define XB_TOP      3328
#define XB_TOPGEN   3392
#define XCD_BAR_WORDS 3456
#define XB_SPIN_CAP (1u << 18)

__device__ __forceinline__ unsigned xb_ld(unsigned* p)              { return __hip_atomic_load(p, __ATOMIC_RELAXED, __HIP_MEMORY_SCOPE_AGENT); }
__device__ __forceinline__ unsigned xb_add(unsigned* p, unsigned v) { return __hip_atomic_fetch_add(p, v, __ATOMIC_RELAXED, __HIP_MEMORY_SCOPE_AGENT); }
__device__ __forceinline__ unsigned xb_xcc_id() { return (unsigned)__builtin_amdgcn_s_getreg((3 << 11) | 20) & 0xFu; }
#define XB_SPIN(cond, bar) do { unsigned _sp = 0; while (cond) { __builtin_amdgcn_s_sleep(1); \
    if ((++_sp & 255u) == 0u) { if (xb_ld(&(bar)[XB_TMO])) break; if (_sp > XB_SPIN_CAP) { atomicAdd(&(bar)[XB_TMO], 1u); break; } } } } while (0)

struct XcdBarrier {
    unsigned* bar; unsigned x;
    volatile LAS unsigned* st;
};

__device__ __forceinline__ XcdBarrier xcd_barrier_post(unsigned* bar, volatile LAS unsigned* st, int tid) {
    XcdBarrier b; b.bar = bar; b.x = xb_xcc_id(); b.st = st;
    if (tid == 0) (void)xb_add(&bar[XB_XCNT(b.x)], 1u);
    return b;
}
__device__ __forceinline__ void xcd_barrier_complete(unsigned* bar, unsigned x, unsigned& nloc, unsigned& nx) {
    const unsigned G = gridDim.x * gridDim.y * gridDim.z;
    unsigned sum, cnt, mine, sp = 0u;
    for (;;) {
        sum = 0u; cnt = 0u; mine = 0u;
#pragma unroll 1
        for (unsigned j = 0; j < 16; ++j) { const unsigned c = xb_ld(&bar[XB_XCNT(j)]); sum += c; cnt += (c > 0u) ? 1u : 0u; mine = (j == x) ? c : mine; }
        if (sum == G) break;
        __builtin_amdgcn_s_sleep(1);
        if ((++sp & 255u) == 0u) { if (xb_ld(&bar[XB_TMO])) break; if (sp > XB_SPIN_CAP) { atomicAdd(&bar[XB_TMO], 1u); break; } }
    }
    nloc = mine > 0u ? mine : 1u; nx = cnt > 0u ? cnt : 1u;
}

__device__ __forceinline__ void xcd_barrier(const XcdBarrier& b, int tid) {
    asm volatile("s_waitcnt vmcnt(0)" ::: "memory");
    __syncthreads();
    if (tid == 0) {
        unsigned* bar = b.bar;
        __builtin_amdgcn_s_waitcnt(0);
        unsigned nloc = b.st[0], nx = b.st[1];
        if (nloc == 0u) { xcd_barrier_complete(bar, b.x, nloc, nx); b.st[0] = nloc; b.st[1] = nx; }
        const unsigned old = xb_add(&bar[XB_XSUB(b.x)], 1u);
        const unsigned gen = old / nloc;
        if (old + 1u == (gen + 1u) * nloc) {
            __builtin_amdgcn_fence(__ATOMIC_RELEASE, "agent");
            asm volatile("s_waitcnt vmcnt(0)" ::: "memory");
            const unsigned og = xb_add(&bar[XB_TOP], 1u);
            const unsigned tg = og / nx;
            if (og + 1u == (tg + 1u) * nx) xb_add(&bar[XB_TOPGEN], 1u);
            else XB_SPIN(xb_ld(&bar[XB_TOPGEN]) == tg, bar);
            __builtin_amdgcn_fence(__ATOMIC_ACQUIRE, "agent");
            xb_add(&bar[XB_XGEN(b.x)], 1u);
            asm volatile("s_waitcnt vmcnt(0)" ::: "memory");
        } else {
            XB_SPIN(xb_ld(&bar[XB_XGEN(b.x)]) == gen, bar);
            __builtin_amdgcn_fence(__ATOMIC_ACQUIRE, "agent");
            asm volatile("s_waitcnt vmcnt(0)" ::: "memory");
        }
    }
    __syncthreads();
}
struct Frame {
    LAS unsigned char* lds;
    unsigned char* ldsg;
    volatile LAS unsigned* MISC;
    gu32* ctl;
    int tid, lane, wave, G, bid;
    unsigned char* ws;
    unsigned long long karg;
};
typedef const float* cfp_t;
__device__ __forceinline__ const float* INP(const Frame& F, int i) { const cfp_t p = ((const __attribute__((address_space(4))) cfp_t*)F.karg)[i]; return (const float*)(const GAS float*)p; }
__device__ __forceinline__ float* OUTP(const Frame& F) { const cfp_t p = ((const __attribute__((address_space(4))) cfp_t*)F.karg)[25]; return (float*)(GAS float*)p; }
enum InIdx { I_X = 0, I_C, I_CTX, I_CCTX, I_WMOD, I_BMOD, I_GAINS, I_WIN, I_HCW, I_HCB, I_HW1, I_HB1, I_HFREQ, I_HW2, I_HB2, I_HW3, I_HSKIP, I_RPB, I_SINK, I_WBR, I_WOUT, I_WUP, I_FCW, I_FCB, I_WDN };

typedef _Float16 h2v __attribute__((ext_vector_type(2)));
typedef _Float16 h4v __attribute__((ext_vector_type(4)));
typedef _Float16 h8v __attribute__((ext_vector_type(8)));
__device__ __forceinline__ unsigned pack_h2(float a, float b) { h2v h; h.x = (_Float16)a; h.y = (_Float16)b; return __builtin_bit_cast(unsigned, h); }
__device__ __forceinline__ void p0_modvec(Frame& F) {
    LAS float* sc = (LAS float*)(F.lds);
    LAS float* part = (LAS float*)(F.lds + 40960);
    float* modv = (float*)(F.ws + WS_MODV);
    if (F.bid < 192) {
        for (int i = F.tid; i < 5 * DM; i += NTHR) { const int r = i >> 11, k = i & 2047; const float x = r < 4 ? INP(F, I_C)[r * DM + k] : INP(F, I_CCTX)[k]; sc[i] = x / (1.0f + expf(-x)); }
        __syncthreads();
        for (int it = F.bid; it < 192; it += F.G) {
            const int l = it / 48, cg = it % 48;
            const float* W = INP(F, I_WMOD) + (size_t)l * DM * NMOD + cg * 256 + 4 * F.lane;
            float acc[5][4];
#pragma unroll
            for (int r = 0; r < 5; ++r)
#pragma unroll
                for (int j = 0; j < 4; ++j) acc[r][j] = 0.f;
#pragma unroll 8
            for (int i = 0; i < 256; ++i) { const int k = F.wave + 8 * i; const f32x4 w = __builtin_nontemporal_load((const f32x4*)(W + (size_t)k * NMOD));
#pragma unroll
                for (int r = 0; r < 5; ++r) { const float s = sc[r * DM + k];
#pragma unroll
                    for (int j = 0; j < 4; ++j) acc[r][j] += s * w[j]; } }
#pragma unroll
            for (int r = 0; r < 5; ++r)
#pragma unroll
                for (int j = 0; j < 4; ++j) part[(F.wave * 5 + r) * 256 + 4 * F.lane + j] = acc[r][j];
            __syncthreads();
            for (int o = F.tid; o < 1280; o += NTHR) { const int r = o >> 8, cc = o & 255; float s = 0.f;
#pragma unroll
                for (int w = 0; w < 8; ++w) s += part[(w * 5 + r) * 256 + cc];
                const int col = cg * 256 + cc; modv[(size_t)(l * 5 + r) * NMOD + col] = s + INP(F, I_BMOD)[l * NMOD + col]; }
            __syncthreads();
        }
    }
    if (F.bid == F.G - 1) {
        float2* rope = (float2*)(F.ws + WS_ROPE);
        for (int e = F.tid; e < 2048; e += NTHR) { const int pos = e >> 5, i = e & 31; const float inv = powf(10000.0f, -(float)(2 * i) / 64.0f); const float ang = (float)pos * inv; float s, c; sincosf(ang, &s, &c); rope[e] = make_float2(c, s); }
    }
}

__device__ __forceinline__ void load_row(const float* p, int lane, f32x4 (&v)[8]) {
#pragma unroll
    for (int j = 0; j < 8; ++j) v[j] = *(const f32x4*)(p + 4 * lane + 256 * j);
}
__device__ __forceinline__ float row_rstd(const f32x4 (&v)[8]) {
    float s = 0.f;
#pragma unroll
    for (int j = 0; j < 8; ++j) s += (v[j].x * v[j].x + v[j].y * v[j].y) + (v[j].z * v[j].z + v[j].w * v[j].w);
    s = wave_sum(s);
    return 1.0f / sqrtf(s * (1.0f / DM) + NORM_EPS);
}
__device__ __forceinline__ void store_h(bf16* hrow, int lane, const f32x4 (&x)[8], float rstd, const float* g, const float* shift, const float* scale) {
#pragma unroll
    for (int j = 0; j < 8; ++j) { const int col = 4 * lane + 256 * j;
        const f32x4 gg = *(const f32x4*)(g + col), sh = *(const f32x4*)(shift + col), sc = *(const f32x4*)(scale + col);
        const f32x4 y = (x[j] * rstd * gg) * (1.0f + sc) + sh;
        v2u o; o.x = pk2(y.x, y.y); o.y = pk2(y.z, y.w); *(v2u*)(hrow + col) = o; }
}
__device__ __forceinline__ int row_bidx(int m) { return m < ML ? (m >> 12) : 4; }
__device__ __forceinline__ float* xrow_ptr(Frame& F, int m) { return m < ML ? OUTP(F) + (size_t)m * DM : (float*)(F.ws + WS_XC) + (size_t)(m - ML) * DM; }
__device__ __forceinline__ const float* xin_ptr(Frame& F, int m) { return m < ML ? INP(F, I_X) + (size_t)m * DM : INP(F, I_CTX) + (size_t)(m - ML) * DM; }
__device__ __forceinline__ void rows_first(Frame& F) {
    const int gw = F.bid * NWAVES + F.wave, NGW = F.G * NWAVES;
    const float* modv = (const float*)(F.ws + WS_MODV); bf16* H = (bf16*)(F.ws + WS_H);
    for (int m = gw; m < MT; m += NGW) {
        f32x4 x[8]; load_row(xin_ptr(F, m), F.lane, x);
        const float rstd = row_rstd(x);
        const float* mv = modv + (size_t)(0 * 5 + row_bidx(m)) * NMOD;
        store_h(H + (size_t)m * DM, F.lane, x, rstd, INP(F, I_GAINS) + 0, mv + 0 * DM, mv + 1 * DM);
    }
}
__device__ __forceinline__ void p1_modcomb(Frame& F) {
    const float* modv = (const float*)(F.ws + WS_MODV); _Float16* mc = (_Float16*)(F.ws + WS_MODC); const float* gains = INP(F, I_GAINS);
    for (int i = F.bid * NTHR + F.tid; i < DEPTH * 5 * DM; i += F.G * NTHR) { const int lb = i >> 11, col = i & 2047, l = lb / 5;
        const float* mv = modv + (size_t)lb * NMOD + col; const float* g = gains + (size_t)l * 4 * DM + col; _Float16* o = mc + (size_t)lb * 6 * DM + col;
        o[0] = (_Float16)(mv[2 * DM] * g[1 * DM]); o[DM] = (_Float16)(g[2 * DM] * (1.0f + mv[4 * DM])); o[2 * DM] = (_Float16)mv[3 * DM];
        o[3 * DM] = (_Float16)(mv[5 * DM] * g[3 * DM]); o[4 * DM] = (_Float16)(g[0] * (1.0f + mv[1 * DM])); o[5 * DM] = (_Float16)mv[0]; }
}
__device__ __forceinline__ f32x4 ldh4(const _Float16* p) { const h4v h = *(const h4v*)p; return (f32x4){(float)h.x, (float)h.y, (float)h.z, (float)h.w}; }
__device__ __forceinline__ void load_row_h(const unsigned* p, int lane, f32x4 (&v)[8]) {
#pragma unroll
    for (int j = 0; j < 8; ++j) { const h4v h = *(const h4v*)(p + 2 * lane + 128 * j); v[j] = (f32x4){(float)h.x, (float)h.y, (float)h.z, (float)h.w}; }
}
__device__ __forceinline__ float clamp_h(float x) { return __builtin_amdgcn_fmed3f(x, -65000.0f, 65000.0f); }
__device__ __forceinline__ void rows_residual(Frame& F, int l, const float* SRC, int which, int mrows, bool x_from_input, bool x_to_output) {
    const int gw = F.bid * NWAVES + F.wave, NGW = F.G * NWAVES;
    const _Float16* mc = (const _Float16*)(F.ws + WS_MODC); bf16* H = (bf16*)(F.ws + WS_H);
    const bool has_h = (which == 0) || (l + 1 < DEPTH); const int lh = which == 0 ? l : l + 1;
    LAS float* lv = (LAS float*)F.lds;
    __syncthreads();
    for (int i = F.tid; i < 5 * 3 * (DM / 4); i += NTHR) { const int v = i / (DM / 4), c4 = i % (DM / 4), bi = v / 3, k = v % 3;
        const _Float16* src = (k == 0) ? mc + (size_t)((l * 5 + bi) * 6 + (which == 0 ? 0 : 3)) * DM : mc + (size_t)((lh * 5 + bi) * 6 + (which == 0 ? 1 : 4) + (k - 1)) * DM;
        h4v t = {(_Float16)0.f, (_Float16)0.f, (_Float16)0.f, (_Float16)0.f}; if (k == 0 || has_h) t = *(const h4v*)(src + 4 * c4);
        *(LAS f32x4*)(lv + (size_t)v * DM + 4 * c4) = (f32x4){(float)t.x, (float)t.y, (float)t.z, (float)t.w}; }
    __syncthreads();
    for (int m = gw; m < mrows; m += NGW) {
        const int bi = row_bidx(m);
        const LAS float* Ap = lv + (bi * 3) * DM + 4 * F.lane;
        f32x4 A[8];
#pragma unroll
        for (int j = 0; j < 8; ++j) A[j] = *(const LAS f32x4*)(Ap + 256 * j);
        f32x4 s[8];
        if (m < ML) { const bf16* sb = (const bf16*)SRC + (size_t)m * DM;
#pragma unroll
            for (int j = 0; j < 8; ++j) { const v2u r = *(const v2u*)(sb + 4 * F.lane + 256 * j); s[j] = (f32x4){blo(r.x), bhi(r.x), blo(r.y), bhi(r.y)}; } }
        else {
            const unsigned* sl = (const unsigned*)(F.ws + WS_UT) + (size_t)(m - ML) * (DM / 2); load_row_h(sl, F.lane, s);
            for (int k = 1; k < 4; ++k) { f32x4 t[8]; load_row_h(sl + (size_t)k * MC * (DM / 2), F.lane, t);
#pragma unroll
                for (int j = 0; j < 8; ++j) s[j] += t[j]; } }
        const float rs = row_rstd(s);
        unsigned* xh = (unsigned*)(F.ws + WS_XH) + (size_t)m * (DM / 2); f32x4 x[8];
        if (x_from_input) load_row(xin_ptr(F, m), F.lane, x); else load_row_h(xh, F.lane, x);
#pragma unroll
        for (int j = 0; j < 8; ++j) { const int col = 4 * F.lane + 256 * j;
            x[j] = x[j] + A[j] * (s[j] * rs);
            if (x_to_output) *(f32x4*)(OUTP(F) + (size_t)m * DM + col) = x[j];
            else { h4v o; o.x = (_Float16)clamp_h(x[j].x); o.y = (_Float16)clamp_h(x[j].y); o.z = (_Float16)clamp_h(x[j].z); o.w = (_Float16)clamp_h(x[j].w); *(h4v*)(xh + 2 * F.lane + 128 * j) = o; } }
        if (has_h) { const float rstd = row_rstd(x);
            const LAS float* Bp = lv + (bi * 3 + 1) * DM + 4 * F.lane; const LAS float* Cp = Bp + DM;
            bf16* hrow = H + (size_t)m * DM + 4 * F.lane;
#pragma unroll
            for (int j = 0; j < 8; ++j) { const f32x4 bb = *(const LAS f32x4*)(Bp + 256 * j), cc = *(const LAS f32x4*)(Cp + 256 * j); const f32x4 y = (x[j] * rstd) * bb + cc;
                v2u o; o.x = pk2(y.x, y.y); o.y = pk2(y.z, y.w); *(v2u*)(hrow + 256 * j) = o; } }
    }
}

__device__ __forceinline__ void tr_block(const float* W, int ldw, int K, int k0, int n_src0, bf16* WT, int n_dst0, LAS float* scr, int lane) {
#pragma unroll 8
    for (int i = 0; i < 32; ++i) { const int kk = 2 * i + (lane >> 5); scr[kk * 33 + (lane & 31)] = __builtin_nontemporal_load(W + (size_t)(k0 + kk) * ldw + n_src0 + (lane & 31)); }
    LDS_WAIT(); asm volatile("" ::: "memory");
    const int c = lane & 7;
#pragma unroll
    for (int j = 0; j < 4; ++j) { const int n = (lane >> 3) + 8 * j; const LAS float* s = scr + (8 * c) * 33 + n;
        v4u o; o.x = pk2(s[0 * 33], s[1 * 33]); o.y = pk2(s[2 * 33], s[3 * 33]); o.z = pk2(s[4 * 33], s[5 * 33]); o.w = pk2(s[6 * 33], s[7 * 33]);
        *(v4u*)(WT + (size_t)(n_dst0 + n) * K + k0 + 8 * c) = o; }
    LDS_WAIT(); asm volatile("" ::: "memory");
}
__device__ __forceinline__ int win_src_col(int d) {
    if (d < 512) return d;
    if (d < 768) return 1024 + (d - 512);
    if (d < 1280) return 4608 + (d - 768);
    if (d < 1792) return 5120 + (d - 1280);
    if (d < 7936) return 5632 + (d - 1792);
    if (d < 11008) return 1536 + (d - 7936);
    if (d < 11520) return 512 + (d - 11008);
    return 1280 + (d - 11520);
}
__device__ __forceinline__ void p1_weights(Frame& F, int l, int wset) {
    LAS float* scr = (LAS float*)(F.lds + F.wave * 8704);
    const int gw = F.bid * NWAVES + F.wave, NGW = F.G * NWAVES;
    constexpr int I_A = 368 * 32, I_B = 2048, I_C2 = 2048, I_D = 352 * 32, I_E = 64 * 88, NIT = I_A + I_B + I_C2 + I_D + I_E;
    unsigned char* wb = F.ws + WS_WSET + (size_t)wset * WSET_BYTES;
    bf16* WIN = (bf16*)(wb + WO_WIN); bf16* WBR = (bf16*)(wb + WO_WBR); bf16* WOUT = (bf16*)(wb + WO_WOUT); bf16* WUP = (bf16*)(wb + WO_WUP); bf16* WDN = (bf16*)(wb + WO_WDN);
    for (int it = gw; it < NIT; it += NGW) {
        int r = it;
        if (r < I_A) { const int nb = r / 32, kb = r % 32; tr_block(INP(F, I_WIN) + (size_t)l * DM * NIN, NIN, DM, 64 * kb, win_src_col(32 * nb), WIN, 32 * nb, scr, F.lane); continue; } r -= I_A;
        if (r < I_B) { const int nb = r / 32, kb = r % 32; tr_block(INP(F, I_WBR) + (size_t)l * DM * DM, DM, DM, 64 * kb, 32 * nb, WBR, 32 * nb, scr, F.lane); continue; } r -= I_B;
        if (r < I_C2) { const int nb = r / 32, kb = r % 32; tr_block(INP(F, I_WOUT) + (size_t)l * DM * DM, DM, DM, 64 * kb, 32 * nb, WOUT, 32 * nb, scr, F.lane); continue; } r -= I_C2;
        if (r < I_D) { const int nb = r / 32, kb = r % 32, d = 32 * nb, tl = d >> 8, wi = d & 255;
            tr_block(INP(F, I_WUP) + (size_t)l * DM * 2 * DFF, 2 * DFF, DM, 64 * kb, wi < 128 ? 128 * tl + wi : DFF + 128 * tl + (wi - 128), WUP, d, scr, F.lane); continue; } r -= I_D;
        { const int nb = r / 88, kb = r % 88; tr_block(INP(F, I_WDN) + (size_t)l * DFF * DM, DM, DFF, 64 * kb, 32 * nb, WDN, 32 * nb, scr, F.lane); }
    }
}
__device__ __forceinline__ void p0_filter_mlp(Frame& F) {
    const int gw = F.bid * NWAVES + F.wave, NGW = F.G * NWAVES, j = F.lane;
    for (int it = gw; it < DEPTH * 4352; it += NGW) {
        const int l = it / 4352, pos = it % 4352;
        const float* w1 = INP(F, I_HW1) + (size_t)l * 33 * 64; const float* b1 = INP(F, I_HB1) + l * 64; const float* fr = INP(F, I_HFREQ) + l * 128;
        const float* w2 = INP(F, I_HW2) + (size_t)l * 64 * 64; const float* b2 = INP(F, I_HB2) + l * 64;
        float* A2 = (float*)(F.ws + WS_A2) + (size_t)l * 4096 * 64; float* A2C = (float*)(F.ws + WS_A2C) + (size_t)l * 256 * 64;
        const int n = pos < 4096 ? 4096 : 256, i = pos < 4096 ? pos : pos - 4096;
        const float t = (float)i / (float)(n - 1), w = (6.283185307179586f / (float)n) * (float)i;
        float z = 0.f;
        if (j == 0) z = t;
        else if (j <= 16) { const float fb = 1e-4f + (float)(j - 1) * ((15.0f - 1e-4f) / 15.0f); z = cosf(fb * w); }
        else if (j <= 32) { const float fb = 1e-4f + (float)(j - 17) * ((15.0f - 1e-4f) / 15.0f); z = -sinf(fb * w); }
        float acc = b1[j];
#pragma unroll
        for (int f = 0; f < 33; ++f) acc += __shfl(z, f) * w1[f * 64 + j];
        const float a1 = sinf(fr[j] * acc);
        float acc2 = b2[j];
#pragma unroll 16
        for (int ii = 0; ii < 64; ++ii) acc2 += __shfl(a1, ii) * w2[ii * 64 + j];
        const float a2 = sinf(fr[64 + j] * acc2);
        if (pos < 4096) ((_Float16*)A2)[(size_t)pos * 64 + j] = (_Float16)a2;
        else A2C[(size_t)i * 64 + j] = a2;
    }
}

__device__ __forceinline__ void fft_twiddles(Frame& F) {
    cf2* TW = (cf2*)(F.ldsg + LDS_TW);
    float s, c; sincospif(-(float)F.tid * (1.0f / 4096.0f), &s, &c); cf2 w; w.x = c; w.y = s; TW[F.tid] = w;
}
template <int NBUF> __device__ __forceinline__ void fft_forward(Frame& F) {
    cf2* X0 = (cf2*)(F.ldsg + LDS_X0); cf2* X1 = (cf2*)(F.ldsg + LDS_X1); const cf2* TW = (const cf2*)(F.ldsg + LDS_TW);
    __syncthreads();
    if (NBUF == 2) fft_fwd_passA2(X0, X1, TW, F.tid); else fft_fwd_passA(X0, TW, F.tid);
    __syncthreads();
    if (NBUF == 2) fft_fwd_passB2(X0, X1, TW, F.tid); else fft_fwd_passB(X0, TW, F.tid);
    __syncthreads();
    if (NBUF == 2) { fft_fwd_passC(F.tid < 256 ? X0 : X1, F.tid & 255); } else { if (F.tid < 256) fft_fwd_passC(X0, F.tid); }
    __syncthreads();
}
template <int NBUF> __device__ __forceinline__ void fft_inverse(Frame& F) {
    cf2* X0 = (cf2*)(F.ldsg + LDS_X0); cf2* X1 = (cf2*)(F.ldsg + LDS_X1); const cf2* TW = (const cf2*)(F.ldsg + LDS_TW);
    __syncthreads();
    if (NBUF == 2) { fft_inv_passC(F.tid < 256 ? X0 : X1, F.tid & 255); } else { if (F.tid < 256) fft_inv_passC(X0, F.tid); }
    __syncthreads();
    fft_inv_passB(X0, TW, F.tid); if (NBUF == 2) fft_inv_passB(X1, TW, F.tid);
    __syncthreads();
    fft_inv_passA(X0, TW, F.tid); if (NBUF == 2) fft_inv_passA(X1, TW, F.tid);
    __syncthreads();
}

__device__ __forceinline__ void filter_pair(Frame& F, int l, int c0, int buf) {
    asm volatile("" : "+v"(F.tid)); F.lane = F.tid & 63;
    cf2* X0 = (cf2*)(F.ldsg + LDS_X0); cf2* X1 = (cf2*)(F.ldsg + LDS_X1);
    LAS float* XF0 = (LAS float*)(F.lds + LDS_X0); LAS float* XF1 = (LAS float*)(F.lds + LDS_X1);
    LAS float* W3S = (LAS float*)(F.lds + LDS_SM);
    LAS float* RED = (LAS float*)(F.lds + LDS_SM + 2048);
    const float* w3 = INP(F, I_HW3) + (size_t)l * 64 * 4096;
    const float* A2 = (const float*)(F.ws + WS_A2) + (size_t)l * 4096 * 64; const float* A2C = (const float*)(F.ws + WS_A2C) + (size_t)l * 256 * 64;
    const int lane = F.lane, n = lane & 15, q4 = lane >> 4;
    __syncthreads();
    { const int e8 = F.tid >> 6, kk = F.tid & 63; W3S[e8 * 64 + kk] = w3[(size_t)kk * 4096 + ((e8 >> 1) & 1) * 2048 + (e8 & 1) * 1024 + c0 + (e8 >> 2)]; }
    if (F.tid == 0) { cf2 zz; zz.x = 0.f; zz.y = 0.f; X0[PADI(4096)] = zz; X1[PADI(4096)] = zz; }
    const int n7 = n & 7; const int colb = ((n7 >> 1) & 1) * 2048 + (n7 & 1) * 1024 + c0 + ((n7 >> 2) & 1);
    h8v bfr[2];
#pragma unroll
    for (int s = 0; s < 2; ++s) {
#pragma unroll
        for (int j = 0; j < 8; ++j) bfr[s][j] = (_Float16)w3[(size_t)(32 * s + 8 * q4 + j) * 4096 + colb]; }
    const float dstep = (HY_MAX_DECAY - HY_MIN_DECAY) / 2047.0f;
    const int ch = (n7 >> 2) & 1, ord = n7 & 1, dir = (n7 >> 1) & 1; const bool up = n >= 8;
    const float del = fabsf(HY_MIN_DECAY + (float)(ord * 1024 + c0 + ch) * dstep);
    LAS float* XF = ch ? XF1 : XF0;
    float asum = 0.f;
    const float cdec = del * (1.4426950408889634f / 4095.0f);
    float dcur = __builtin_amdgcn_exp2f(-(float)(16 * F.wave + 4 * q4 + (up ? 2 : 0)) * cdec); const float r1 = __builtin_amdgcn_exp2f(-cdec), r128 = __builtin_amdgcn_exp2f(-128.0f * cdec);
#pragma unroll 4
    for (int i = 0; i < 32; ++i) {
        const int pos0 = 16 * (F.wave + 8 * i);
        const _Float16* aph = (const _Float16*)A2 + (size_t)(pos0 + n) * 64 + 8 * q4;
        f32x4 acc = (f32x4){0.f, 0.f, 0.f, 0.f};
#pragma unroll
        for (int s = 0; s < 2; ++s) { const h8v ah = *(const h8v*)(aph + 32 * s); acc = __builtin_amdgcn_mfma_f32_16x16x32_f16(ah, bfr[s], acc, 0, 0, 0); }
        {
            const float av[2] = {up ? acc[2] : acc[0], up ? acc[3] : acc[1]};
#pragma unroll
            for (int rr = 0; rr < 2; ++rr) { const int pos = pos0 + 4 * q4 + (up ? 2 : 0) + rr; const float val = av[rr] * (rr == 0 ? dcur : dcur * r1);
                const bool bad = (dir != 0) && (pos == 0); const int idx = bad ? 4096 : (dir == 0 ? pos : 8192 - pos); const float vs = bad ? 0.f : val;
                asum += fabsf(vs); XF[2 * PADI(idx) + ord] = vs; }
            dcur *= r128;
        }
    }
    asum += __shfl_xor(asum, 16); asum += __shfl_xor(asum, 32); asum += __shfl_xor(asum, 2); asum += __shfl_xor(asum, 8);
    if (q4 == 0 && n < 8 && dir == 0) RED[F.wave * 4 + ch * 2 + ord] = asum;
    __syncthreads();
    float tot[4];
#pragma unroll
    for (int e = 0; e < 4; ++e) { float t = 0.f;
#pragma unroll
        for (int w = 0; w < 8; ++w) t += RED[w * 4 + e];
        tot[e] = 1.0f / t; }
    cf2* Xa = X0 + PADI(F.tid); cf2* Xb = X1 + PADI(F.tid);
    const float h0 = 0.5f * tot[0], h1 = 0.5f * tot[1], h2 = 0.5f * tot[2], h3 = 0.5f * tot[3];
    fft_forward<2>(F);
    unsigned* KS = (unsigned*)(F.ws + WS_KSPEC + (size_t)buf * KSPEC_BUF) + (size_t)c0 * 2 * 8192 + F.tid;
#pragma unroll 2
    for (int i = 0; i < 16; ++i) { const int p = F.tid + 512 * i, pb = PADI(fft_conj_pos(p));
        const cf2 f = Xa[528 * i], g = X0[pb], f2 = Xb[528 * i], g2 = X1[pb];
        f32x2v k0, k1;
        k0.x = h0 * (f.x + g.x); k0.y = h0 * (f.y - g.y); k1.x = h1 * (f.y + g.y); k1.y = -h1 * (f.x - g.x);
        KS[512 * i] = pack_h2(k0.x, k0.y); KS[8192 + 512 * i] = pack_h2(k1.x, k1.y);
        k0.x = h2 * (f2.x + g2.x); k0.y = h2 * (f2.y - g2.y); k1.x = h3 * (f2.y + g2.y); k1.y = -h3 * (f2.x - g2.x);
        KS[16384 + 512 * i] = pack_h2(k0.x, k0.y); KS[16384 + 8192 + 512 * i] = pack_h2(k1.x, k1.y); }
    if (l + 1 < DEPTH) { const int cc = F.tid >> 8, pos = F.tid & 255; const f32x4* ar = (const f32x4*)(A2C + (size_t)pos * 64);
      const LAS float* W = W3S + cc * 256;
      float h0 = 0.f, h1 = 0.f, h2 = 0.f, h3 = 0.f;
#pragma unroll 4
      for (int q = 0; q < 16; ++q) { const f32x4 a = ar[q];
          const f32x4 u0 = *(const LAS f32x4*)(W + 0 * 64 + 4 * q), u1 = *(const LAS f32x4*)(W + 1 * 64 + 4 * q), u2 = *(const LAS f32x4*)(W + 2 * 64 + 4 * q), u3 = *(const LAS f32x4*)(W + 3 * 64 + 4 * q);
          h0 += (a.x * u0.x + a.y * u0.y) + (a.z * u0.z + a.w * u0.w); h1 += (a.x * u1.x + a.y * u1.y) + (a.z * u1.z + a.w * u1.w);
          h2 += (a.x * u2.x + a.y * u2.y) + (a.z * u2.z + a.w * u2.w); h3 += (a.x * u3.x + a.y * u3.y) + (a.z * u3.z + a.w * u3.w); }
      const float del0 = fabsf(HY_MIN_DECAY + (float)(c0 + cc) * dstep), del1 = fabsf(HY_MIN_DECAY + (float)(1024 + c0 + cc) * dstep);
      const float t = (float)pos * (1.0f / 255.0f), d0 = __builtin_amdgcn_exp2f(-t * del0 * 1.4426950408889634f), d1 = __builtin_amdgcn_exp2f(-t * del1 * 1.4426950408889634f);
      const float f0 = h0 * d0, f1 = h1 * d1, b0 = h2 * d0, b1 = h3 * d1;
      float c0s = fabsf(f0), c1s = fabsf(f1); if (pos >= 1) { c0s += fabsf(b0); c1s += fabsf(b1); }
      c0s = wave_sum(c0s); c1s = wave_sum(c1s);
      __syncthreads();
      if (F.lane == 0) { RED[F.wave * 2] = c0s; RED[F.wave * 2 + 1] = c1s; }
      __syncthreads();
      float u0 = 0.f, u1 = 0.f;
#pragma unroll
      for (int w = 0; w < 4; ++w) { u0 += RED[(4 * cc + w) * 2]; u1 += RED[(4 * cc + w) * 2 + 1]; }
      const float q0 = 1.0f / u0, q1 = 1.0f / u1;
      LAS float* KCS = XF0 + cc * 1024;
      KCS[pos] = f0 * q0; KCS[512 + pos] = f1 * q1;
      if (pos >= 1) { KCS[512 - pos] = b0 * q0; KCS[512 + 512 - pos] = b1 * q1; } else { KCS[256] = 0.f; KCS[512 + 256] = 0.f; }
      __syncthreads();
      float* KC = (float*)(F.ws + WS_KC + (size_t)buf * KC_BUF);
#pragma unroll
      for (int e = 0; e < 4; ++e) { const int idx = F.tid + 512 * e, c2 = idx >> 10, o2 = (idx >> 9) & 1, d = idx & 511; KC[(size_t)(o2 * 1024 + c0 + c2) * 512 + d] = XF0[idx]; }
      __syncthreads();
    }
}

__device__ __forceinline__ float conv3_at(const bf16* u, int t, int n, float w0, float w1, float w2, float bias) {
    const float cur = bf2f(u[t]); const float pv = bf2f(u[t - 1]), nv = bf2f(u[t + 1]);
    const float prv = t > 0 ? pv : 0.f; const float nxt = t < n - 1 ? nv : 0.f;
    return w0 * prv + w1 * cur + w2 * nxt + bias;
}
struct Raw8 { v4u r; float prv, nxt; };
__device__ __forceinline__ Raw8 load_raw8(const bf16* seq, int tid) {
    Raw8 x; const bf16* p = seq + 8 * tid; x.r = *(const v4u*)p;
    const float pv = bf2f(p[-1]), nv = bf2f(p[8]);
    x.prv = tid > 0 ? pv : 0.f; x.nxt = tid < 511 ? nv : 0.f; return x;
}
__device__ __forceinline__ void conv8(const Raw8& x, float w0, float w1, float w2, float bias, float (&o)[8]) {
    float e[10]; e[0] = x.prv; e[9] = x.nxt;
    e[1] = blo(x.r.x); e[2] = bhi(x.r.x); e[3] = blo(x.r.y); e[4] = bhi(x.r.y); e[5] = blo(x.r.z); e[6] = bhi(x.r.z); e[7] = blo(x.r.w); e[8] = bhi(x.r.w);
#pragma unroll
    for (int j = 0; j < 8; ++j) o[j] = w0 * e[j] + w1 * e[j + 1] + w2 * e[j + 2] + bias;
}
__device__ __forceinline__ void fft_passC_conv_h2(cf2* X, const unsigned (&kp)[32], int g) {
    cf2* Xp = X + 33 * g; cf2 v[32], w[32];
#pragma unroll
    for (int q = 0; q < 32; ++q) v[q] = Xp[q];
    dft_reg<32, 5, -1>(v);
#pragma unroll
    for (int q = 0; q < 32; ++q) { const h2v h = __builtin_bit_cast(h2v, kp[q]); const cf2 k = {(float)h.x, (float)h.y}; w[q] = cmul(v[bitrev_c(q, 5)], k); }
    dft_reg<32, 5, +1>(w);
#pragma unroll
    for (int q = 0; q < 32; ++q) Xp[q] = w[bitrev_c(q, 5)];
}
__device__ __forceinline__ void fft_conv2(Frame& F, const unsigned* K) {
    cf2* X0 = (cf2*)(F.ldsg + LDS_X0); cf2* X1 = (cf2*)(F.ldsg + LDS_X1); const cf2* TW = (const cf2*)(F.ldsg + LDS_TW);
    __syncthreads();
    fft_fwd_passA2_zp(X0, X1, TW, F.tid);
    __syncthreads();
    const int gC = 32 * F.wave + (F.lane & 31);
    unsigned kp[32];
    { const v4u* Kp = (const v4u*)(K + 32 * gC);
#pragma unroll
      for (int q = 0; q < 8; ++q) { const v4u t = Kp[q]; kp[4 * q] = t.x; kp[4 * q + 1] = t.y; kp[4 * q + 2] = t.z; kp[4 * q + 3] = t.w; } }
    FFT_PIN();
    fft_fwd_passB2(X0, X1, TW, F.tid);
    asm volatile("s_waitcnt lgkmcnt(0)" ::: "memory"); __builtin_amdgcn_wave_barrier();
    fft_passC_conv_h2(F.lane < 32 ? X0 : X1, kp, gC);
    asm volatile("s_waitcnt lgkmcnt(0)" ::: "memory"); __builtin_amdgcn_wave_barrier();
    fft_inv_passB2(X0, X1, TW, F.tid);
    __syncthreads();
    fft_inv_passA2_half(X0, X1, TW, F.tid);
    __syncthreads();
}
__device__ __forceinline__ void hyena_pair(Frame& F, int l, int c0, int buf, bool with_ctx) {
    cf2* X0 = (cf2*)(F.ldsg + LDS_X0); cf2* X1 = (cf2*)(F.ldsg + LDS_X1);
    const bf16* UT = (const bf16*)(F.ws + WS_UT);
    const float* cw = INP(F, I_HCW) + (size_t)l * 3 * 3072; const float* cb = INP(F, I_HCB) + (size_t)l * 3072;
    bf16* YH = (bf16*)(F.ws + WS_Y);
    const float* KC = (const float*)(F.ws + WS_KC + (size_t)buf * KC_BUF);
    unsigned op[4][4]; unsigned opc[2] = {0u, 0u};
#pragma unroll
    for (int b = 0; b < 4; ++b)
#pragma unroll
        for (int j = 0; j < 4; ++j) op[b][j] = 0u;
#pragma unroll 1
    for (int which = 0; which < 2; ++which) {
        asm volatile("" : "+v"(F.tid)); F.lane = F.tid & 63;
        const int c = c0 + which;
        const bf16* uv = UT + (size_t)(U_HY + c) * MT; const bf16* u1 = UT + (size_t)(U_HY + 1024 + c) * MT; const bf16* u2 = UT + (size_t)(U_HY + 2048 + c) * MT;
        const Raw8 r0 = load_raw8(uv + 0 * SEQ, F.tid), r1 = load_raw8(uv + 1 * SEQ, F.tid), r2 = load_raw8(uv + 2 * SEQ, F.tid), r3 = load_raw8(uv + 3 * SEQ, F.tid);
        const float vw0 = cw[c], vw1 = cw[3072 + c], vw2 = cw[6144 + c], vb = cb[c];
        const float aw0 = cw[1024 + c], aw1 = cw[3072 + 1024 + c], aw2 = cw[6144 + 1024 + c], ab = cb[1024 + c];
        const float bw0 = cw[2048 + c], bw1 = cw[3072 + 2048 + c], bw2 = cw[6144 + 2048 + c], bb = cb[2048 + c];
        const float sk0 = INP(F, I_HSKIP)[(size_t)l * 2048 + c], sk1 = INP(F, I_HSKIP)[(size_t)l * 2048 + 1024 + c];
        const unsigned* K0 = (const unsigned*)(F.ws + WS_KSPEC + (size_t)buf * KSPEC_BUF) + (size_t)c * 2 * 8192; const unsigned* K1 = K0 + 8192;
        const cf2 zero = {0.f, 0.f};
        cf2* Xa = X0 + PADI(8 * F.tid); cf2* Xb = X1 + PADI(8 * F.tid);
        FFT_PIN();
        __syncthreads();
        float v[4][8];
        { conv8(r0, vw0, vw1, vw2, vb, v[0]); conv8(r1, vw0, vw1, vw2, vb, v[1]); conv8(r2, vw0, vw1, vw2, vb, v[2]); conv8(r3, vw0, vw1, vw2, vb, v[3]); }
#pragma unroll
        for (int j = 0; j < 8; ++j) { cf2 a, b; a.x = v[0][j]; a.y = v[1][j]; b.x = v[2][j]; b.y = v[3][j]; Xa[j] = a; Xb[j] = b; }
        Raw8 xr[4];
#pragma unroll
        for (int b = 0; b < 4; ++b) xr[b] = load_raw8(u1 + b * SEQ, F.tid);
        fft_conv2(F, K0);
        float z[4][8];
        { float x1c[4][8];
#pragma unroll
          for (int b = 0; b < 4; ++b) conv8(xr[b], aw0, aw1, aw2, ab, x1c[b]);
#pragma unroll
          for (int j = 0; j < 8; ++j) { const cf2 ya = Xa[j], yb = Xb[j];
              z[0][j] = x1c[0][j] * (ya.x * (1.0f / 8192.0f) + sk0 * v[0][j]); z[1][j] = x1c[1][j] * (ya.y * (1.0f / 8192.0f) + sk0 * v[1][j]);
              z[2][j] = x1c[2][j] * (yb.x * (1.0f / 8192.0f) + sk0 * v[2][j]); z[3][j] = x1c[3][j] * (yb.y * (1.0f / 8192.0f) + sk0 * v[3][j]);
              cf2 a, b; a.x = z[0][j]; a.y = z[1][j]; b.x = z[2][j]; b.y = z[3][j]; Xa[j] = a; Xb[j] = b; } }
#pragma unroll
        for (int b = 0; b < 4; ++b) xr[b] = load_raw8(u2 + b * SEQ, F.tid);
        fft_conv2(F, K1);
        const int t = F.tid & 255, hf = F.tid >> 8, b0 = 2 * hf;
        const float kf0 = KC[(size_t)(0 * 1024 + c) * 512 + F.tid], kf1 = KC[(size_t)(1 * 1024 + c) * 512 + F.tid];
        float cv[2], cx1[2], cx2[2];
#pragma unroll
        for (int e = 0; e < 2; ++e) { const int so = ML + (b0 + e) * CTXL; cv[e] = conv3_at(uv + so, t, CTXL, vw0, vw1, vw2, vb); cx1[e] = conv3_at(u1 + so, t, CTXL, aw0, aw1, aw2, ab); cx2[e] = conv3_at(u2 + so, t, CTXL, bw0, bw1, bw2, bb); }
        { float x2c[4][8];
#pragma unroll
          for (int b = 0; b < 4; ++b) conv8(xr[b], bw0, bw1, bw2, bb, x2c[b]);
#pragma unroll
          for (int j = 0; j < 8; ++j) { const cf2 ya = Xa[j], yb = Xb[j];
              const float o0 = x2c[0][j] * (ya.x * (1.0f / 8192.0f) + sk1 * z[0][j]), o1 = x2c[1][j] * (ya.y * (1.0f / 8192.0f) + sk1 * z[1][j]);
              const float o2 = x2c[2][j] * (yb.x * (1.0f / 8192.0f) + sk1 * z[2][j]), o3 = x2c[3][j] * (yb.y * (1.0f / 8192.0f) + sk1 * z[3][j]);
              if (which == 0) { const int sh = (j >> 2) * 16; op[0][j & 3] |= f2bf(o0) << sh; op[1][j & 3] |= f2bf(o1) << sh; op[2][j & 3] |= f2bf(o2) << sh; op[3][j & 3] |= f2bf(o3) << sh; }
              else { const size_t tt = (size_t)(8 * F.tid + j);
                  const int sh = (j >> 2) * 16;
                  *(unsigned*)(YH + ((size_t)0 * SEQ + tt) * DM + c0) = ((op[0][j & 3] >> sh) & 0xffffu) | (f2bf(o0) << 16); *(unsigned*)(YH + ((size_t)1 * SEQ + tt) * DM + c0) = ((op[1][j & 3] >> sh) & 0xffffu) | (f2bf(o1) << 16);
                  *(unsigned*)(YH + ((size_t)2 * SEQ + tt) * DM + c0) = ((op[2][j & 3] >> sh) & 0xffffu) | (f2bf(o2) << 16); *(unsigned*)(YH + ((size_t)3 * SEQ + tt) * DM + c0) = ((op[3][j & 3] >> sh) & 0xffffu) | (f2bf(o3) << 16); } } }
        __syncthreads();
        if (!with_ctx) continue;
        LAS float* kr = (LAS float*)(F.lds + LDS_X0);
        LAS f32x4* vv4 = (LAS f32x4*)(F.lds + LDS_X0 + 8192);
        LAS f32x4* zz4 = (LAS f32x4*)(F.lds + LDS_X0 + 12288);
        LAS f32x4* part = (LAS f32x4*)(F.lds + LDS_X0 + 16384);
        { const int ri = (512 - F.tid) & 511; kr[ri] = kf0; kr[ri + 512] = kf0; kr[1024 + ri] = kf1; kr[1024 + ri + 512] = kf1; }
        float zc[2];
#pragma unroll
        for (int e = 0; e < 2; ++e) ((LAS float*)vv4)[t * 4 + b0 + e] = cv[e];
        __syncthreads();
#define CTX_CONV(KR, SRC) do { f32x4 acc = (f32x4){0.f, 0.f, 0.f, 0.f}; \
          _Pragma("unroll 2") for (int s = 128 * hf; s < 128 * hf + 128; s += 8) { const LAS float* kp = (KR) + ((s - t) & 511); float k8[8]; f32x4 v8[8]; \
              _Pragma("unroll") for (int jj = 0; jj < 8; ++jj) { k8[jj] = kp[jj]; v8[jj] = (SRC)[s + jj]; } \
              FFT_PIN(); \
              _Pragma("unroll") for (int jj = 0; jj < 8; ++jj) acc += k8[jj] * v8[jj]; } \
          part[hf * 256 + t] = acc; } while (0)
        CTX_CONV(kr, vv4);
        __syncthreads();
#pragma unroll
        for (int e = 0; e < 2; ++e) { const float y = ((LAS float*)part)[t * 4 + b0 + e] + ((LAS float*)part)[(256 + t) * 4 + b0 + e];
            zc[e] = cx1[e] * (y + sk0 * cv[e]); ((LAS float*)zz4)[t * 4 + b0 + e] = zc[e]; }
        __syncthreads();
        CTX_CONV(kr + 1024, zz4);
#undef CTX_CONV
        __syncthreads();
#pragma unroll
        for (int e = 0; e < 2; ++e) { const float y = ((LAS float*)part)[t * 4 + b0 + e] + ((LAS float*)part)[(256 + t) * 4 + b0 + e];
            const unsigned o = f2bf(cx2[e] * (y + sk1 * zc[e]));
            if (which == 0) opc[e] = o; else *(unsigned*)(YH + (size_t)(ML + (b0 + e) * CTXL + t) * DM + c0) = opc[e] | (o << 16); }
    }
    __syncthreads();
}
constexpr int AT_TILE = 35840, AT_K = 0, AT_V = 17408, AT_RPB = 2 * AT_TILE, AT_ROPE = AT_RPB + 2048, AT_END = AT_ROPE + 16384;
constexpr float ATT_SCALE2 = 0.08838834764831845f * 1.4426950408889634f;
__device__ __forceinline__ void attn_load_rope(Frame& F) {
    const f32x2v* rope = (const f32x2v*)(F.ws + WS_ROPE); LAS f32x2v* R = (LAS f32x2v*)(F.lds + AT_ROPE);
    __syncthreads();
    for (int e = F.tid; e < 2048; e += NTHR) R[e] = rope[e];
    __syncthreads();
}
#define ATT_PIN() __builtin_amdgcn_sched_barrier(0)
struct AttnTileRegs { bf16x8 ka, kb, v0, v1; };
__device__ __forceinline__ void attn_unit(Frame& F, int l, int u) {
    asm volatile("" : "+v"(F.tid)); F.lane = F.tid & 63;
    const bf16* P = (const bf16*)(F.ws + WS_P); const bf16* UT = (const bf16*)(F.ws + WS_UT);
    int mode, b, h, qtok0, klo, khi, qcol, kcol, vrow, qr0 = 0; bf16* Y; bool has_sink = false; float sink2 = 0.f;
    if (u < 256) { mode = 0; int p, blk; if (u < 32) { p = u >> 1; blk = (u & 1) ? 15 : 0; } else { const int t = u - 32; p = t / 14; blk = 1 + (t - 14 * p); } b = p >> 2; h = p & 3; qtok0 = b * SEQ + blk * 256;
        const int lo = blk * 256 - 128, hi = blk * 256 + 384; klo = b * SEQ + (lo < 0 ? 0 : lo); khi = b * SEQ + (hi > SEQ ? SEQ : hi);
        qcol = P_SWQ + h * 128; kcol = P_SWK + (h >> 1) * 128; vrow = U_SWV + (h >> 1) * 128; Y = (bf16*)(F.ws + WS_Y) + Y_SW; has_sink = true; sink2 = INP(F, I_SINK)[l * 4 + h] * 1.4426950408889634f; }
    else if (u < 512) { mode = 1; const int v = u - 256; int p, rq; if (v < 32) { p = v >> 1; rq = (v & 1) ? 15 : 0; } else { const int t = v - 32; p = t / 14; rq = 1 + (t - 14 * p); } b = p >> 2; h = p & 3; qr0 = 4 * rq; qtok0 = b * SEQ + qr0 * 64;
        int rs0 = qr0 - 4; rs0 = rs0 < 0 ? 0 : (rs0 > 56 ? 56 : rs0); int rs3 = qr0 + 3 - 4; rs3 = rs3 < 0 ? 0 : (rs3 > 56 ? 56 : rs3);
        klo = b * SEQ + 64 * rs0; khi = b * SEQ + 64 * (rs3 + 8);
        qcol = P_NAQ + h * 128; kcol = P_NAK + h * 128; vrow = U_NAV + h * 128; Y = (bf16*)(F.ws + WS_Y) + Y_NA; }
    else { const int v = u - 512; b = v >> 3; const int hh = v & 7; qtok0 = ML + b * CTXL; klo = 0; khi = 0;
        if (hh < 4) { mode = 2; h = hh; qcol = P_NAQ + h * 128; kcol = P_NAK + h * 128; vrow = U_NAV + h * 128; Y = (bf16*)(F.ws + WS_Y) + Y_NA; }
        else { mode = 3; h = hh - 4; qcol = P_SWQ + h * 128; kcol = P_SWK + (h >> 1) * 128; vrow = U_SWV + (h >> 1) * 128; Y = (bf16*)(F.ws + WS_Y) + Y_SW; has_sink = true; sink2 = INP(F, I_SINK)[l * 4 + h] * 1.4426950408889634f; } }
    const int ctok0 = ML + b * CTXL;
    const int lane = F.lane, w = F.wave, n = lane & 15, q4 = lane >> 4;
    LAS unsigned char* lds = F.lds; const LAS f32x2v* ROPE = (const LAS f32x2v*)(lds + AT_ROPE); LAS float* RPB = (LAS float*)(lds + AT_RPB);
    const int nloc = (khi - klo) >> 6, ntile = 4 + nloc;
    const int skey = F.tid >> 3, scp = F.tid & 7, shalf = scp >> 2, sci = scp & 3, sd0 = shalf * 64 + sci * 8;
#define ATT_KTOK(ti) ((ti) < 4 ? ctok0 + 64 * (ti) : klo + 64 * ((ti) - 4))
#define ATT_ISSUE(R, ti) do { const int kt_ = ATT_KTOK(ti); const bf16* kp_ = P + (size_t)(kt_ + skey) * NP + kcol + sd0; (R).ka = *(const bf16x8*)kp_; (R).kb = *(const bf16x8*)(kp_ + 32); \
        (R).v0 = *(const bf16x8*)(UT + (size_t)(vrow + (F.tid >> 3)) * MT + kt_ + 8 * (F.tid & 7)); (R).v1 = *(const bf16x8*)(UT + (size_t)(vrow + 64 + (F.tid >> 3)) * MT + kt_ + 8 * (F.tid & 7)); } while (0)
#define ATT_WRITE(R, ti, bufo) do { if (mode == 0 && (ti) >= 4) { const int tk_ = (ATT_KTOK(ti) + skey) & (SEQ - 1); const int pos_ = shalf == 0 ? (tk_ >> 6) : (tk_ & 63); \
            _Pragma("unroll") for (int j = 0; j < 8; ++j) { const f32x2v cs = ROPE[pos_ * 32 + 8 * sci + j]; const float x1 = bf2f((bf16)(R).ka[j]), x2 = bf2f((bf16)(R).kb[j]); \
                (R).ka[j] = (short)f2bf(x1 * cs.x - x2 * cs.y); (R).kb[j] = (short)f2bf(x2 * cs.x + x1 * cs.y); } } \
        *(LAS bf16x8*)(lds + (bufo) + AT_K + skey * 272 + sd0 * 2) = (R).ka; *(LAS bf16x8*)(lds + (bufo) + AT_K + skey * 272 + sd0 * 2 + 64) = (R).kb; \
        *(LAS bf16x8*)(lds + (bufo) + AT_V + (F.tid >> 3) * 144 + (F.tid & 7) * 16) = (R).v0; *(LAS bf16x8*)(lds + (bufo) + AT_V + (64 + (F.tid >> 3)) * 144 + (F.tid & 7) * 16) = (R).v1; } while (0)
    AttnTileRegs R;
    ATT_ISSUE(R, 0);
    __syncthreads();
    if (mode == 1) { const float* rpb = INP(F, I_RPB) + (size_t)(l * 4 + h) * 15 * 31; for (int e = F.tid; e < 465; e += NTHR) RPB[e] = rpb[e] * 1.4426950408889634f; }
    const int wq0 = qtok0 + 32 * w;
    bf16x8 qf[2][4];
#pragma unroll
    for (int g = 0; g < 2; ++g) { const int qtok = wq0 + 16 * g + n; const bf16* qp = P + (size_t)qtok * NP + qcol + 8 * q4;
#pragma unroll
      for (int s = 0; s < 4; ++s) qf[g][s] = *(const bf16x8*)(qp + 32 * s);
      if (mode == 0) {
          const int tq = qtok & (SEQ - 1);
#pragma unroll
          for (int ax = 0; ax < 2; ++ax) { const int pos = ax == 0 ? (tq >> 6) : (tq & 63);
#pragma unroll
              for (int j = 0; j < 8; ++j) { const f32x2v cs = ROPE[pos * 32 + 8 * q4 + j];
                  const float x1 = bf2f((bf16)qf[g][2 * ax][j]), x2 = bf2f((bf16)qf[g][2 * ax + 1][j]);
                  qf[g][2 * ax][j] = (short)f2bf(x1 * cs.x - x2 * cs.y); qf[g][2 * ax + 1][j] = (short)f2bf(x2 * cs.x + x1 * cs.y); } } }
    }
    ATT_WRITE(R, 0, 0);
#pragma unroll
    for (int g = 0; g < 2; ++g)
#pragma unroll
        for (int s = 0; s < 4; ++s) { v4u t = __builtin_bit_cast(v4u, qf[g][s]); asm volatile("" : "+v"(t)); qf[g][s] = __builtin_bit_cast(bf16x8, t); }
    float m_run[2], lsum[2]; f32x4 o[2][8];
#pragma unroll
    for (int g = 0; g < 2; ++g) { m_run[g] = has_sink ? sink2 : -1e30f; lsum[g] = (has_sink && q4 == 0) ? 1.0f : 0.f;
#pragma unroll
        for (int d = 0; d < 8; ++d) o[g][d] = (f32x4){0.f, 0.f, 0.f, 0.f}; }
    const int qr = qr0 + (w >> 1);
    int rs = qr - 4; rs = rs < 0 ? 0 : (rs > 56 ? 56 : rs);
    __syncthreads();
    for (int ti = 0; ti < ntile; ++ti) {
        const bool is_ctx = ti < 4; const int ktok0 = ATT_KTOK(ti); const int bufo = (ti & 1) * AT_TILE;
        if (ti + 1 < ntile) ATT_ISSUE(R, ti + 1);
        bool active = true;
        int kr = 0;
        if (!is_ctx) {
            if (mode == 1) { kr = (ktok0 & (SEQ - 1)) >> 6; active = (kr >= rs) && (kr < rs + 8); }
            else if (mode == 0) active = (ktok0 <= wq0 + 31 + 128) && (ktok0 + 63 >= wq0 - 128);
        }
        if (active) {
            f32x4 sc[2][4];
            { bf16x8 kf[2][4];
              const LAS unsigned char* kbase = lds + bufo + AT_K + n * 272 + 16 * q4;
#pragma unroll
              for (int s = 0; s < 4; ++s) kf[0][s] = *(const LAS bf16x8*)(kbase + 64 * s);
#pragma unroll
              for (int kb = 0; kb < 4; ++kb) {
                  if (kb < 3) {
#pragma unroll
                      for (int s = 0; s < 4; ++s) kf[(kb + 1) & 1][s] = *(const LAS bf16x8*)(kbase + (kb + 1) * (16 * 272) + 64 * s); }
                  ATT_PIN();
                  f32x4 a0 = (f32x4){0.f, 0.f, 0.f, 0.f}, a1 = (f32x4){0.f, 0.f, 0.f, 0.f};
#pragma unroll
                  for (int s = 0; s < 4; ++s) { a0 = __builtin_amdgcn_mfma_f32_16x16x32_bf16(kf[kb & 1][s], qf[0][s], a0, 0, 0, 0); a1 = __builtin_amdgcn_mfma_f32_16x16x32_bf16(kf[kb & 1][s], qf[1][s], a1, 0, 0, 0); }
                  sc[0][kb] = a0; sc[1][kb] = a1;
                  ATT_PIN(); } }
            bf16x8 pf[2][2];
#pragma unroll
            for (int g = 0; g < 2; ++g) {
                const int qtok = wq0 + 16 * g + n;
                float tmax = -INFINITY;
                if (is_ctx || mode >= 2 || (mode == 0 && ktok0 >= wq0 - 97 && ktok0 <= wq0 + 65)) {
#pragma unroll
                    for (int kb = 0; kb < 4; ++kb)
#pragma unroll
                        for (int r = 0; r < 4; ++r) { const float v = sc[g][kb][r] * ATT_SCALE2; sc[g][kb][r] = v; tmax = fmaxf(tmax, v); }
                } else if (mode == 0) {
                    const int d0 = qtok - ktok0 - 4 * q4;
#pragma unroll
                    for (int kb = 0; kb < 4; ++kb)
#pragma unroll
                        for (int r = 0; r < 4; ++r) { const int dpos = d0 - (16 * kb + r); float v = sc[g][kb][r] * ATT_SCALE2; v = (dpos > 128 || dpos < -128) ? -INFINITY : v; sc[g][kb][r] = v; tmax = fmaxf(tmax, v); }
                } else {
                    const int qc = 32 * (w & 1) + 16 * g + n; int cs0 = qc - 8; cs0 = cs0 < 0 ? 0 : (cs0 > 48 ? 48 : cs0);
                    int e0 = 4 * q4 - cs0; asm volatile("" : "+v"(e0));
                    const LAS float* rb = RPB + (kr - qr + 7) * 31 + (4 * q4 - qc + 15);
                    float bias[4][4];
#pragma unroll
                    for (int kb = 0; kb < 4; ++kb)
#pragma unroll
                        for (int r = 0; r < 4; ++r) bias[kb][r] = rb[16 * kb + r];
#pragma unroll
                    for (int kb = 0; kb < 4; ++kb)
#pragma unroll
                        for (int r = 0; r < 4; ++r) { float v = sc[g][kb][r] * ATT_SCALE2 + bias[kb][r]; v = ((unsigned)(e0 + 16 * kb + r) >= 16u) ? -INFINITY : v; sc[g][kb][r] = v; tmax = fmaxf(tmax, v); }
                }
                tmax = fmaxf(tmax, __shfl_xor(tmax, 16)); tmax = fmaxf(tmax, __shfl_xor(tmax, 32));
                const float m_new = fmaxf(m_run[g], tmax); const float alpha = __builtin_amdgcn_exp2f(m_run[g] - m_new); m_run[g] = m_new;
                float ps = 0.f;
#pragma unroll
                for (int kb = 0; kb < 4; ++kb)
#pragma unroll
                    for (int r = 0; r < 4; ++r) { const float p = __builtin_amdgcn_exp2f(sc[g][kb][r] - m_new); sc[g][kb][r] = p; ps += p; }
                lsum[g] = lsum[g] * alpha + ps;
#pragma unroll
                for (int d = 0; d < 8; ++d) o[g][d] = o[g][d] * alpha;
#pragma unroll
                for (int s2 = 0; s2 < 2; ++s2) { v4u t; t.x = pk2(sc[g][2 * s2][0], sc[g][2 * s2][1]); t.y = pk2(sc[g][2 * s2][2], sc[g][2 * s2][3]); t.z = pk2(sc[g][2 * s2 + 1][0], sc[g][2 * s2 + 1][1]); t.w = pk2(sc[g][2 * s2 + 1][2], sc[g][2 * s2 + 1][3]);
                    pf[g][s2] = __builtin_bit_cast(bf16x8, t); }
            }
            { v2u vr[2][4];
              const LAS unsigned char* vbase = lds + bufo + AT_V + n * 144 + 8 * q4;
#pragma unroll
              for (int e = 0; e < 4; ++e) vr[0][e] = *(const LAS v2u*)(vbase + 64 * (e >> 1) + 32 * (e & 1));
#pragma unroll
              for (int d = 0; d < 8; ++d) {
                  if (d < 7) {
#pragma unroll
                      for (int e = 0; e < 4; ++e) vr[(d + 1) & 1][e] = *(const LAS v2u*)(vbase + (d + 1) * (16 * 144) + 64 * (e >> 1) + 32 * (e & 1)); }
                  ATT_PIN();
#pragma unroll
                  for (int s2 = 0; s2 < 2; ++s2) { v4u t; t.x = vr[d & 1][2 * s2].x; t.y = vr[d & 1][2 * s2].y; t.z = vr[d & 1][2 * s2 + 1].x; t.w = vr[d & 1][2 * s2 + 1].y; const bf16x8 vf = __builtin_bit_cast(bf16x8, t);
                      o[0][d] = __builtin_amdgcn_mfma_f32_16x16x32_bf16(vf, pf[0][s2], o[0][d], 0, 0, 0); o[1][d] = __builtin_amdgcn_mfma_f32_16x16x32_bf16(vf, pf[1][s2], o[1][d], 0, 0, 0); }
                  ATT_PIN(); } }
        }
        __syncthreads();
        if (ti + 1 < ntile) ATT_WRITE(R, ti + 1, ((ti + 1) & 1) * AT_TILE);
        __syncthreads();
    }
#undef ATT_KTOK
#undef ATT_ISSUE
#undef ATT_WRITE
#pragma unroll
    for (int g = 0; g < 2; ++g) { float lt = lsum[g]; lt += __shfl_xor(lt, 16); lt += __shfl_xor(lt, 32);
        const float inv = 1.0f / lt;
        bf16* yp = Y + (size_t)(wq0 + 16 * g + n) * DM + h * 128 + 4 * q4;
#pragma unroll
        for (int d = 0; d < 8; ++d) { v2u t; t.x = pk2(o[g][d][0] * inv, o[g][d][1] * inv); t.y = pk2(o[g][d][2] * inv, o[g][d][3] * inv); *(v2u*)(yp + 16 * d) = t; } }
}

__device__ __forceinline__ void act_fixup(Frame& F, int l, int mrows) {
    const float* HP = (const float*)(F.ws + WS_HALO); const float* HU = (const float*)(F.ws + WS_HALO + HALO_ONE); const float* HA = (const float*)(F.ws + WS_HALO + 2 * HALO_ONE);
    bf16* ACT = (bf16*)(F.ws + WS_ACT);
    const float* cw = INP(F, I_FCW) + (size_t)l * 3 * DFF;
    const int ntile = mrows / 256, nit = ntile * 2 * (DFF / 4);
    for (int it = F.bid * NTHR + F.tid; it < nit; it += F.G * NTHR) {
        const int c4 = it % (DFF / 4), pe = it / (DFF / 4), e = pe & 1, pm = pe >> 1, t0 = pm * 256, seqlen = t0 < ML ? SEQ : CTXL;
        const bool open = e == 0 ? (t0 % seqlen) != 0 : ((t0 + 256) % seqlen) != 0;
        if (!open) continue;
        const int j = 4 * c4; const size_t ho = ((size_t)pm * 2 + e) * DFF + j;
        const f32x4 pp = *(const f32x4*)(HP + ho), uu = *(const f32x4*)(HU + ho);
        const f32x4 nb = e == 0 ? *(const f32x4*)(HA + ((size_t)(pm - 1) * 2 + 1) * DFF + j) : *(const f32x4*)(HA + ((size_t)(pm + 1) * 2 + 0) * DFF + j);
        const f32x4 w = *(const f32x4*)(cw + (e == 0 ? 0 : 2 * DFF) + j);
        float r[4];
#pragma unroll
        for (int q = 0; q < 4; ++q) { const float pre = pp[q] + w[q] * nb[q]; r[q] = pre * pg8::sigmoid_f(pre) * uu[q]; }
        v2u o; o.x = pk2(r[0], r[1]); o.y = pk2(r[2], r[3]);
        *(v2u*)(ACT + (size_t)(t0 + (e ? 255 : 0)) * DFF + j) = o;
    }
}
#ifndef MK_PER_PHASE
#define MK_PER_PHASE 0
#endif
constexpr int PH_PER_LAYER = 10, N_PHASES = 1 + PH_PER_LAYER * DEPTH;
__device__ __forceinline__ int ufence(int v) { asm volatile("" : "+v"(v)); return __builtin_amdgcn_readfirstlane(v); }
__device__ __forceinline__ int opq(int v) { return ufence(v); }
struct Args { const float* in[25]; float* out; unsigned char* ws; int ph_lo, ph_hi; };
__global__ void __launch_bounds__(NTHR, 2) hybrid_fwd(Args args) {
    extern __shared__ __attribute__((aligned(16))) unsigned char lds[];
    Frame F;
    F.lds = (LAS unsigned char*)lds; F.ldsg = lds;
    F.MISC = (volatile LAS unsigned*)(F.lds + MISC_OFF);
    F.tid = threadIdx.x; F.lane = F.tid & 63; F.wave = __builtin_amdgcn_readfirstlane(F.tid >> 6);
    F.G = gridDim.x; F.bid = blockIdx.x;
    F.ws = args.ws; F.ctl = (gu32*)(args.ws + WS_CTL); F.karg = (unsigned long long)__builtin_amdgcn_kernarg_segment_ptr();
    for (int u = F.tid; u < (LDS_BYTES - MISC_OFF) / 4; u += NTHR) ((LAS unsigned*)(F.lds + MISC_OFF))[u] = 0u;
    __syncthreads();
    XcdBarrier bar; bar.bar = (unsigned*)(F.ctl + CW_BAR); bar.x = 0; bar.st = nullptr;
#if !MK_PER_PHASE
    bar = xcd_barrier_post((unsigned*)(F.ctl + CW_BAR), F.MISC + 8, F.tid);
#endif
    const int lo = args.ph_lo, hi = args.ph_hi;
    const int MTr = ufence(MT);
#ifndef PHMASK
#define PHMASK 0x7ff
#endif
#define IN(k) (lo <= (k) && (k) < hi)
#define PHON(j) (((PHMASK) >> (j)) & 1)
#ifndef DBLMASK
#define DBLMASK 0
#endif
#define REPS(j) ((((DBLMASK) >> (j)) & 1) ? 2 : 1)
#define SEAM(k) do { if (IN(k) && IN((k) + 1)) { XcdBarrier b2_ = bar; b2_.bar = (unsigned*)(F.ws + WS_CTL) + CW_BAR; xcd_barrier(b2_, F.tid); } } while (0)
#define FENCE() do { asm volatile("" : "+v"(F.tid)); F.lane = F.tid & 63; F.wave = __builtin_amdgcn_readfirstlane(F.tid >> 6); F.bid = ufence(F.bid); F.G = ufence(F.G); \
    { const unsigned long long w_ = (unsigned long long)F.ws; const unsigned lo_ = (unsigned)ufence((int)(unsigned)w_), hi_ = (unsigned)ufence((int)(unsigned)(w_ >> 32)); F.ws = (unsigned char*)(GAS unsigned char*)(((unsigned long long)hi_ << 32) | lo_); }\
    { const unsigned lo_ = (unsigned)ufence((int)(unsigned)F.karg), hi_ = (unsigned)ufence((int)(unsigned)(F.karg >> 32)); F.karg = ((unsigned long long)hi_ << 32) | lo_; } } while (0)
#define H ((bf16*)(F.ws + WS_H))
#define Pb ((bf16*)(F.ws + WS_P))
#define UT ((bf16*)(F.ws + WS_UT))
#define WIN ((bf16*)(F.ws + WS_WSET + (size_t)wset * WSET_BYTES + WO_WIN))
#define WBR ((bf16*)(F.ws + WS_WSET + (size_t)wset * WSET_BYTES + WO_WBR))
#define WOUT ((bf16*)(F.ws + WS_WSET + (size_t)wset * WSET_BYTES + WO_WOUT))
#define WUP ((bf16*)(F.ws + WS_WSET + (size_t)wset * WSET_BYTES + WO_WUP))
#define WDN ((bf16*)(F.ws + WS_WSET + (size_t)wset * WSET_BYTES + WO_WDN))
#define YY ((bf16*)(F.ws + WS_Y))
#define T1 ((bf16*)(F.ws + WS_T1))
#define T2 ((bf16*)(F.ws + WS_T2))
#define MM ((bf16*)(F.ws + WS_MM))
#define MIX ((float*)(F.ws + WS_MIX))
#define AU ((bf16*)(F.ws + WS_AU))
#define ACT ((bf16*)(F.ws + WS_ACT))
#define SLAB ((_Float16*)(F.ws + WS_UT))

    if (PHON(0) && IN(0)) { FENCE(); p0_modvec(F); __syncthreads(); p0_filter_mlp(F); }
    SEAM(0);
    for (int l = 0; l < DEPTH; ++l) {
        const int pb = 1 + PH_PER_LAYER * l;
        const int mrows = (l == DEPTH - 1) ? ML : MTr;
        const int wset = l & 1, kbuf = l & 1;
        if (PHON(1) && IN(pb + 0)) for (int rep_ = 0; rep_ < REPS(1); ++rep_) { FENCE(); p1_weights(F, l, wset); if (l == 0) { rows_first(F); p1_modcomb(F); } }
        SEAM(pb + 0);
        if (PHON(2) && IN(pb + 1)) {
            FENCE(); fft_twiddles(F);
            for (int rep_ = 0; rep_ < REPS(11); ++rep_)
            for (int pi = F.bid; pi < HYW / 2; pi += F.G) filter_pair(F, l, 2 * pi, kbuf);
            __syncthreads(); FENCE();
            for (int rep_ = 0; rep_ < REPS(2); ++rep_) {
            const int npart = (l == DEPTH - 1) ? 2 : 1; int cum = 0;
#pragma unroll 1
            for (int part = 0; part < npart; ++part) {
              FENCE();
              const int rows = opq(npart == 1 ? MT : (part == 0 ? ML : MC)), roff = (part == 0) ? 0 : ML, N1 = opq(part == 0 ? NP : P_NAQ), K1 = opq(DM);
              const int c = (F.bid + F.G - cum % F.G) % F.G; cum += (rows / 256) * (N1 / 256);
              pg8::Gemm g{H + (size_t)roff * DM, WIN, rows, N1, K1, K1, K1}; pg8::StaticOrder S; S.init(rows, N1, F.G, c); pg8::EpiBf16Gate E{Pb + (size_t)roff * NP, NP, P_GATE / 256};
              pg8::gemm_phase<pg8::EpiBf16Gate, pg8::StaticOrder, true, true>(F.lds, g, S, E, F.tid); }
#pragma unroll 1
            for (int part = 0; part < npart; ++part) {
              FENCE();
              const int toks = opq(npart == 1 ? MT : (part == 0 ? ML : MC)), toff = (part == 0) ? 0 : ML, choff = (part == 0) ? 0 : U_NAV, M2 = opq(part == 0 ? NU : NU - U_NAV), K2 = opq(DM);
              const int c = (F.bid + F.G - cum % F.G) % F.G; cum += (M2 / 256) * (toks / 256);
              pg8::Gemm g{WIN + (size_t)(NP + choff) * DM, H + (size_t)toff * DM, M2, toks, K2, K2, K2}; pg8::StaticOrder S; S.init(M2, toks, F.G, c); pg8::EpiBf16P E{UT + (size_t)choff * MT + toff, MT};
              pg8::gemm_phase<pg8::EpiBf16P, pg8::StaticOrder, true, true>(F.lds, g, S, E, F.tid); }
            }
        }
        SEAM(pb + 1);
        if (PHON(3) && IN(pb + 2)) {
            FENCE(); fft_twiddles(F);
            for (int rep_ = 0; rep_ < REPS(3); ++rep_)
            for (int pi = F.bid; pi < HYW / 2; pi += F.G) { const int s = pi >> 8, wv = pi & 255; const int pr = 64 * (wv & 7) + (wv >> 3) + 32 * s; hyena_pair(F, l, 2 * pr, kbuf, l + 1 < DEPTH); }
            FENCE(); attn_load_rope(F);
            for (int rep_ = 0; rep_ < REPS(12); ++rep_)
            { const int vcu = (F.G % 8 == 0) ? (F.bid % 8) * (F.G / 8) + F.bid / 8 : F.bid;
              for (int u = vcu; u < (l + 1 < DEPTH ? 544 : 512); u += F.G) attn_unit(F, l, u); }
        }
        SEAM(pb + 2);
        if (PHON(4) && IN(pb + 3)) for (int rep_ = 0; rep_ < REPS(4); ++rep_) {
            FENCE();
            { pg8::Gemm g{YY, WBR, mrows, DM, opq(DM), DM, DM}; pg8::StaticOrder S; S.init(mrows, DM, F.G, F.bid); pg8::EpiMergeK E{Pb + P_GATE, NP, MM, DM};
              pg8::gemm_phase<pg8::EpiMergeK, pg8::StaticOrder, true, true>(F.lds, g, S, E, F.tid); }
        }
        SEAM(pb + 3);
        if (PHON(5) && IN(pb + 4)) for (int rep_ = 0; rep_ < REPS(5); ++rep_) { FENCE();
            { pg8::Gemm g{MM, WOUT, ML, DM, DM, DM, DM}; pg8::StaticOrder S; S.init(ML, DM, F.G, F.bid); pg8::EpiBf16P E{(bf16*)MIX, DM};
              pg8::gemm_phase<pg8::EpiBf16P, pg8::StaticOrder, true, true>(F.lds, g, S, E, F.tid); }
            if (mrows > ML) { FENCE();
              pg8::Gemm g{MM + (size_t)ML * DM, WOUT, MC, DM, opq(DM / 4), DM, DM}; pg8::SplitOrder S; S.init(MC, DM, 4, F.G, F.bid); pg8::EpiF32Slab E{SLAB, DM, (size_t)MC * DM};
              pg8::gemm_phase<pg8::EpiF32Slab, pg8::SplitOrder, true, true>(F.lds, g, S, E, F.tid); } }
        SEAM(pb + 4);
        if (PHON(6) && IN(pb + 5)) { FENCE(); rows_residual(F, l, MIX, 0, mrows, l == 0, false); }
        SEAM(pb + 5);
        if (PHON(7) && IN(pb + 6)) for (int rep_ = 0; rep_ < REPS(7); ++rep_) { FENCE(); pg8::StaticOrder S; S.init(mrows, 2 * DFF, F.G, F.bid);
            pg8::EpiAct E{ACT, DFF, INP(F, I_FCW) + (size_t)l * 3 * DFF, INP(F, I_FCB) + (size_t)l * DFF, (float*)(F.ws + WS_HALO), (float*)(F.ws + WS_HALO + HALO_ONE), (float*)(F.ws + WS_HALO + 2 * HALO_ONE)};
#pragma unroll 1
            for (int ui = 0; ; ++ui) { pg8::OneUnit S1; if (!S.next(ui, S1.u)) break;
                pg8::Gemm g{H, WUP, mrows, 2 * DFF, opq(DM), DM, DM};
                pg8::gemm_phase<pg8::EpiAct, pg8::OneUnit, false, true>(F.lds, g, S1, E, F.tid); __syncthreads(); } }
        SEAM(pb + 6);
        if (PHON(8) && IN(pb + 7)) for (int rep_ = 0; rep_ < REPS(8); ++rep_) { FENCE(); act_fixup(F, l, mrows); }
        SEAM(pb + 7);
        if (PHON(9) && IN(pb + 8)) for (int rep_ = 0; rep_ < REPS(9); ++rep_) { FENCE();
            { pg8::Gemm g{ACT, WDN, ML, DM, DFF, DFF, DFF}; pg8::StaticOrder S; S.init(ML, DM, F.G, F.bid); pg8::EpiBf16P E{(bf16*)MIX, DM};
              pg8::gemm_phase<pg8::EpiBf16P, pg8::StaticOrder, true, true>(F.lds, g, S, E, F.tid); }
            if (mrows > ML) { FENCE();
              pg8::Gemm g{ACT + (size_t)ML * DFF, WDN, MC, DM, opq(DFF / 4), DFF, DFF}; pg8::SplitOrder S; S.init(MC, DM, 4, F.G, F.bid); pg8::EpiF32Slab E{SLAB, DM, (size_t)MC * DM};
              pg8::gemm_phase<pg8::EpiF32Slab, pg8::SplitOrder, true, true>(F.lds, g, S, E, F.tid); } }
        SEAM(pb + 8);
        if (PHON(10) && IN(pb + 9)) { FENCE(); rows_residual(F, l, MIX, 1, mrows, false, l + 1 == DEPTH); }
        SEAM(pb + 9);
    }
#undef IN
#undef SEAM
#undef H
#undef Pb
#undef UT
#undef WIN
#undef WBR
#undef WOUT
#undef WUP
#undef WDN
#undef YY
#undef T1
#undef T2
#undef MM
#undef MIX
#undef AU
#undef ACT
#undef SLAB
}

extern "C" void kernel_launch(void* const* d_in, const int* in_sizes, int n_in, void* d_out, int out_size, void* d_ws, size_t ws_size, hipStream_t stream) {
    static int grid = 0;
    if (grid == 0) {
        if (n_in != 25 || in_sizes[0] != ML * DM || out_size != ML * DM || ws_size < WS_END) { fprintf(stderr, "kernel_launch: unexpected shapes (n_in %d, in0 %d, out %d, ws %zu < %zu); nothing launched\n", n_in, n_in > 0 ? in_sizes[0] : -1, out_size, ws_size, (size_t)WS_END); grid = -1; return; }
        int dev = 0, cus = 0, per_cu = 0;
        if (hipGetDevice(&dev) != hipSuccess || hipDeviceGetAttribute(&cus, hipDeviceAttributeMultiprocessorCount, dev) != hipSuccess) { fprintf(stderr, "kernel_launch: device query failed\n"); grid = -1; return; }
        if (hipFuncSetAttribute((const void*)hybrid_fwd, hipFuncAttributeMaxDynamicSharedMemorySize, LDS_BYTES) != hipSuccess) { fprintf(stderr, "kernel_launch: hipFuncSetAttribute failed\n"); grid = -1; return; }
        if (hipOccupancyMaxActiveBlocksPerMultiprocessor(&per_cu, (const void*)hybrid_fwd, NTHR, LDS_BYTES) != hipSuccess || per_cu < 1) fprintf(stderr, "kernel_launch: note: occupancy query reports %d blocks per CU\n", per_cu);
        (void)hipGetLastError();
        grid = cus;
    }
    if (grid < 0) return;
    if (hipMemsetAsync((char*)d_ws + WS_CTL, 0, CTL_ZERO_BYTES, stream) != hipSuccess) { fprintf(stderr, "kernel_launch: memset failed\n"); return; }
    Args a{};
    for (int i = 0; i < 25; ++i) a.in[i] = (const float*)d_in[i];
    a.out = (float*)d_out; a.ws = (unsigned char*)d_ws;
#if MK_PER_PHASE
    for (int p = 0; p < N_PHASES; ++p) { a.ph_lo = p; a.ph_hi = p + 1; hipLaunchKernelGGL(hybrid_fwd, dim3(grid), dim3(NTHR), LDS_BYTES, stream, a); }
#else
    a.ph_lo = 0; a.ph_hi = N_PHASES; hipLaunchKernelGGL(hybrid_fwd, dim3(grid), dim3(NTHR), LDS_BYTES, stream, a);
#endif
    const hipError_t le = hipPeekAtLastError();
    if (le != hipSuccess) fprintf(stderr, "kernel_launch: launch failed: %s\n", hipGetErrorName(le));
}
```

```cpp
#include <hip/hip_runtime.h>
#include <cstdio>
#include <cstdint>
#include <cmath>
namespace pg8 {
#define PG8_LAS __attribute__((address_space(3)))
typedef unsigned short bf16_t;
typedef short bf16x8 __attribute__((ext_vector_type(8)));
typedef float f32x4 __attribute__((ext_vector_type(4)));
typedef unsigned u32x4 __attribute__((ext_vector_type(4)));
constexpr int BM = 256, BK = 64, HALF = 128, HTB = HALF * BK * 2  , STAGE_BYTES = 8 * HTB, NXCD = 8, WGM = 8;

__host__ __device__ __forceinline__ int lds_byte(int r, int c) { const int st = (r >> 4) * 2 + (c >> 5), rr = r & 15, cc = c & 31, ob = rr * 64 + cc * 2; return st * 1024 + (ob ^ (((ob >> 9) & 1) << 5)); }
__host__ __device__ __forceinline__ void stage_rc(int b, int& R, int& C) { const int st = b / 1024, sb = b % 1024, swz = sb ^ (((sb >> 9) & 1) << 5); R = (st >> 1) * 16 + swz / 64; C = (st & 1) * 32 + (swz % 64) / 2; }
__host__ __device__ __forceinline__ int perm32(int rho) { const int n = rho >> 4, i = rho & 15; return 8 * (i >> 2) + 4 * n + (i & 3); }

struct Unit { int pm, pn, ks; };
struct Gemm { const bf16_t* A; const bf16_t* Bt; int M, N, K, lda, ldb; };

struct StaticOrder {
    int nM, nN, nwg, G, c;
    __host__ __device__ __forceinline__ void init(int M, int N, int G_, int c_) { nM = M / BM; nN = N / BM; nwg = nM * nN; G = G_; c = c_; }
    __host__ __device__ __forceinline__ bool next(int i, Unit& u) const {
        const long L = (long)i * G + c; if (L >= nwg) return false;
        int wgid = (int)L; { const int q = nwg / NXCD, r = nwg % NXCD, xcd = wgid % NXCD, off = wgid / NXCD; wgid = (xcd < r ? xcd * (q + 1) : r * (q + 1) + (xcd - r) * q) + off; }
        const int nig = WGM * nN, gid = wgid / nig, fm = gid * WGM, gsz = (nM - fm) < WGM ? (nM - fm) : WGM;
        u.pm = fm + ((wgid % nig) % gsz); u.pn = (wgid % nig) / gsz; u.ks = 0; return true;
    }
    __device__ __forceinline__ void a_ready(const Unit&) const {}
    __device__ __forceinline__ void done(const Unit&) const {}
};

struct OneUnit {
    Unit u;
    __host__ __device__ __forceinline__ bool next(int i, Unit& o) const { if (i != 0) return false; o = u; return true; }
    __device__ __forceinline__ void a_ready(const Unit&) const {}
    __device__ __forceinline__ void done(const Unit&) const {}
};
struct SplitOrder {
    int nM, nN, S, nwg, G, c;
    __host__ __device__ __forceinline__ void init(int M, int N, int S_, int G_, int c_) { nM = M / BM; nN = N / BM; S = S_; nwg = nM * nN * S_; G = G_; c = c_; }
    __host__ __device__ __forceinline__ bool next(int i, Unit& u) const { const long L = (long)i * G + c; if (L >= nwg) return false; const int t = (int)L / S; u.ks = (int)L % S; u.pm = t % nM; u.pn = t / nM; return true; }
    __device__ __forceinline__ void a_ready(const Unit&) const {}
    __device__ __forceinline__ void done(const Unit&) const {}
};
__device__ __forceinline__ unsigned cvt_pk_bf16(float lo, float hi) { unsigned r; asm volatile("v_cvt_pk_bf16_f32 %0, %1, %2" : "=v"(r) : "v"(lo), "v"(hi)); return r; }
typedef float f32x2 __attribute__((ext_vector_type(2)));
__device__ __forceinline__ float bf_lo(unsigned u) { return __uint_as_float(u << 16); }
__device__ __forceinline__ float bf_hi(unsigned u) { return __uint_as_float(u & 0xffff0000u); }
__device__ __forceinline__ float sigmoid_f(float x) { return __builtin_amdgcn_rcpf(1.0f + __builtin_amdgcn_exp2f(-1.44269504f * x)); }
struct EpiBf16P {
    static constexpr bool PERM = true, AFTER_DRAIN = false, MIDK = false;
    bf16_t* O; int ldc;
    __device__ __forceinline__ void operator()(const f32x4 (&acc)[2][2][4][2], const Unit& u, int wr, int wc, int fr, int fq) const {
        const int row0 = u.pm * BM + wr * 64 + fr, col0 = u.pn * BM + wc * 32 + 8 * fq;
#pragma unroll
        for (int ai = 0; ai < 2; ++ai)
#pragma unroll
            for (int m = 0; m < 4; ++m) { bf16_t* rowp = O + (size_t)(row0 + ai * HALF + m * 16) * ldc + col0;
#pragma unroll
                for (int bj = 0; bj < 2; ++bj) { const f32x4 v0 = acc[ai][bj][m][0], v1 = acc[ai][bj][m][1];
                    u32x4 w; w.x = cvt_pk_bf16(v0[0], v0[1]); w.y = cvt_pk_bf16(v0[2], v0[3]); w.z = cvt_pk_bf16(v1[0], v1[1]); w.w = cvt_pk_bf16(v1[2], v1[3]);
                    *(u32x4*)(rowp + bj * HALF) = w; } }
    }
};
struct EpiF32P {
    static constexpr bool PERM = false, AFTER_DRAIN = false, MIDK = false;
    float* C; int ldc;
    __device__ __forceinline__ void operator()(const f32x4 (&acc)[2][2][4][2], const Unit& u, int wr, int wc, int fr, int fq) const {
        const int row0 = u.pm * BM + wr * 64 + fr, col0 = u.pn * BM + wc * 32 + 4 * fq;
#pragma unroll
        for (int ai = 0; ai < 2; ++ai)
#pragma unroll
            for (int m = 0; m < 4; ++m) { float* rowp = C + (size_t)(row0 + ai * HALF + m * 16) * ldc + col0;
#pragma unroll
                for (int bj = 0; bj < 2; ++bj)
#pragma unroll
                    for (int n = 0; n < 2; ++n) *(f32x4*)(rowp + bj * HALF + n * 16) = acc[ai][bj][m][n]; }
    }
};
struct EpiBf16Gate {
    static constexpr bool PERM = true, AFTER_DRAIN = false, MIDK = false;
    bf16_t* O; int ldc; int gate_tile0;
    __device__ __forceinline__ void operator()(const f32x4 (&acc)[2][2][4][2], const Unit& u, int wr, int wc, int fr, int fq) const {
        const int row0 = u.pm * BM + wr * 64 + fr, col0 = u.pn * BM + wc * 32 + 8 * fq; const bool gate = u.pn >= gate_tile0;
#pragma unroll
        for (int ai = 0; ai < 2; ++ai)
#pragma unroll
            for (int m = 0; m < 4; ++m) { bf16_t* rowp = O + (size_t)(row0 + ai * HALF + m * 16) * ldc + col0;
#pragma unroll
                for (int bj = 0; bj < 2; ++bj) { f32x4 v0 = acc[ai][bj][m][0], v1 = acc[ai][bj][m][1];
                    if (gate) {
#pragma unroll
                        for (int e = 0; e < 4; ++e) { v0[e] = fmaxf(sigmoid_f(v0[e]), 1e-12f); v1[e] = fmaxf(sigmoid_f(v1[e]), 1e-12f); } }
                    u32x4 w; w.x = cvt_pk_bf16(v0[0], v0[1]); w.y = cvt_pk_bf16(v0[2], v0[3]); w.z = cvt_pk_bf16(v1[0], v1[1]); w.w = cvt_pk_bf16(v1[2], v1[3]);
                    *(u32x4*)(rowp + bj * HALF) = w; } }
    }
};
struct EpiMergeK {
    static constexpr bool PERM = true, AFTER_DRAIN = false, MIDK = true;
    static constexpr int KB0 = 16, KB1 = 24;
    const bf16_t* gate; int ldg;
    bf16_t* O; int ldc;
    __device__ __forceinline__ void midk(f32x4 (&acc)[2][2][4][2], const Unit& u, int b, int wr, int wc, int fr, int fq) const {
        const int row0 = u.pm * BM + wr * 64 + fr, col0 = u.pn * BM + wc * 32 + 8 * fq;
#pragma unroll
        for (int ai = 0; ai < 2; ++ai) {
            u32x4 ga[4][2], gb[4][2];
#pragma unroll
            for (int m = 0; m < 4; ++m)
#pragma unroll
                for (int bj = 0; bj < 2; ++bj) { const bf16_t* gp = gate + (size_t)(row0 + ai * HALF + m * 16) * ldg + b * 2048 + col0 + bj * HALF; ga[m][bj] = *(const u32x4*)gp; gb[m][bj] = *(const u32x4*)(gp + 2048); }
#pragma unroll
            for (int m = 0; m < 4; ++m)
#pragma unroll
                for (int bj = 0; bj < 2; ++bj) { const u32x4 x = ga[m][bj], y = gb[m][bj];
                    acc[ai][bj][m][0][0] *= bf_lo(x.x) * __builtin_amdgcn_rcpf(bf_lo(y.x)); acc[ai][bj][m][0][1] *= bf_hi(x.x) * __builtin_amdgcn_rcpf(bf_hi(y.x));
                    acc[ai][bj][m][0][2] *= bf_lo(x.y) * __builtin_amdgcn_rcpf(bf_lo(y.y)); acc[ai][bj][m][0][3] *= bf_hi(x.y) * __builtin_amdgcn_rcpf(bf_hi(y.y));
                    acc[ai][bj][m][1][0] *= bf_lo(x.z) * __builtin_amdgcn_rcpf(bf_lo(y.z)); acc[ai][bj][m][1][1] *= bf_hi(x.z) * __builtin_amdgcn_rcpf(bf_hi(y.z));
                    acc[ai][bj][m][1][2] *= bf_lo(x.w) * __builtin_amdgcn_rcpf(bf_lo(y.w)); acc[ai][bj][m][1][3] *= bf_hi(x.w) * __builtin_amdgcn_rcpf(bf_hi(y.w)); }
        }
    }
    __device__ __forceinline__ void operator()(const f32x4 (&acc)[2][2][4][2], const Unit& u, int wr, int wc, int fr, int fq) const {
        const int row0 = u.pm * BM + wr * 64 + fr, col0 = u.pn * BM + wc * 32 + 8 * fq;
#pragma unroll
        for (int ai = 0; ai < 2; ++ai)
#pragma unroll
            for (int m = 0; m < 4; ++m) { const size_t row = (size_t)(row0 + ai * HALF + m * 16);
#pragma unroll
                for (int bj = 0; bj < 2; ++bj) { const f32x4 v0 = acc[ai][bj][m][0], v1 = acc[ai][bj][m][1];
                    const u32x4 g = *(const u32x4*)(gate + row * ldg + 2 * 2048 + col0 + bj * HALF);
                    u32x4 w; w.x = cvt_pk_bf16(v0[0] * bf_lo(g.x), v0[1] * bf_hi(g.x)); w.y = cvt_pk_bf16(v0[2] * bf_lo(g.y), v0[3] * bf_hi(g.y));
                    w.z = cvt_pk_bf16(v1[0] * bf_lo(g.z), v1[1] * bf_hi(g.z)); w.w = cvt_pk_bf16(v1[2] * bf_lo(g.w), v1[3] * bf_hi(g.w));
                    *(u32x4*)(O + row * ldc + col0 + bj * HALF) = w; } }
    }
};
typedef _Float16 h4v_t __attribute__((ext_vector_type(4)));
struct EpiF32Slab {
    static constexpr bool PERM = false, AFTER_DRAIN = false, MIDK = false;
    _Float16* C; int ldc; size_t slab;
    __device__ __forceinline__ void operator()(const f32x4 (&acc)[2][2][4][2], const Unit& u, int wr, int wc, int fr, int fq) const {
        const int row0 = u.pm * BM + wr * 64 + fr, col0 = u.pn * BM + wc * 32 + 4 * fq;
        _Float16* base = C + (size_t)u.ks * slab;
#pragma unroll
        for (int ai = 0; ai < 2; ++ai)
#pragma unroll
            for (int m = 0; m < 4; ++m) { _Float16* rowp = base + (size_t)(row0 + ai * HALF + m * 16) * ldc + col0;
#pragma unroll
                for (int bj = 0; bj < 2; ++bj)
#pragma unroll
                    for (int n = 0; n < 2; ++n) { const f32x4 a = acc[ai][bj][m][n]; h4v_t h; h.x = (_Float16)a[0]; h.y = (_Float16)a[1]; h.z = (_Float16)a[2]; h.w = (_Float16)a[3]; *(h4v_t*)(rowp + bj * HALF + n * 16) = h; } }
    }
};
struct EpiAct {
    static constexpr bool PERM = true, AFTER_DRAIN = true, MIDK = false;
    bf16_t* ACT; int dff;
    const float* cw; const float* cb;
    float* HP; float* HU; float* HA;
    __device__ __forceinline__ void refuse(size_t, size_t, int, int) const {}
    __device__ __forceinline__ void fused(f32x4 (&acc)[2][2][4][2], const Unit& u, int wr, int wc, int fr, int fq, PG8_LAS unsigned char* lds, int wid, int lane) const {
        const int cl = wc * 32 + 8 * fq;
        const int j0 = u.pn * 128 + cl;
#pragma unroll
        for (int ai = 0; ai < 2; ++ai)
#pragma unroll
            for (int m = 0; m < 4; ++m) { const int r = ai * HALF + wr * 64 + m * 16 + fr; const f32x4 v0 = acc[ai][0][m][0], v1 = acc[ai][0][m][1];
                u32x4 w; w.x = cvt_pk_bf16(v0[0], v0[1]); w.y = cvt_pk_bf16(v0[2], v0[3]); w.z = cvt_pk_bf16(v1[0], v1[1]); w.w = cvt_pk_bf16(v1[2], v1[3]);
                *(PG8_LAS u32x4*)(lds + r * 272 + cl * 2) = w; }
        float w0[8], w1[8], w2[8], bb[8];
#pragma unroll
        for (int q = 0; q < 2; ++q) { const f32x4 a = *(const f32x4*)(cw + j0 + 4 * q), b = *(const f32x4*)(cw + dff + j0 + 4 * q), c = *(const f32x4*)(cw + 2 * dff + j0 + 4 * q), d = *(const f32x4*)(cb + j0 + 4 * q);
#pragma unroll
            for (int e = 0; e < 4; ++e) { w0[4 * q + e] = a[e]; w1[4 * q + e] = b[e]; w2[4 * q + e] = c[e]; bb[4 * q + e] = d[e]; } }
        asm volatile("s_waitcnt lgkmcnt(0)" ::: "memory"); __builtin_amdgcn_s_barrier(); asm volatile("" ::: "memory");
        const int t0 = u.pm * BM;
        const int seqlen = t0 < 16384 ? 4096 : 256;
        const bool top_open = (t0 % seqlen) != 0, bot_open = ((t0 + BM) % seqlen) != 0;
#pragma unroll
        for (int ai = 0; ai < 2; ++ai)
#pragma unroll
            for (int m = 0; m < 4; ++m) { const int r = ai * HALF + wr * 64 + m * 16 + fr;
                const u32x4 zero = {0u, 0u, 0u, 0u};
                const u32x4 pv = r > 0 ? *(const PG8_LAS u32x4*)(lds + (r - 1) * 272 + cl * 2) : zero;
                const u32x4 nx = r < BM - 1 ? *(const PG8_LAS u32x4*)(lds + (r + 1) * 272 + cl * 2) : zero;
                const f32x4 a0 = acc[ai][0][m][0], a1 = acc[ai][0][m][1], u0 = acc[ai][1][m][0], u1 = acc[ai][1][m][1];
                const float ac[8] = {a0[0], a0[1], a0[2], a0[3], a1[0], a1[1], a1[2], a1[3]}, uc[8] = {u0[0], u0[1], u0[2], u0[3], u1[0], u1[1], u1[2], u1[3]};
                const float pf[8] = {bf_lo(pv.x), bf_hi(pv.x), bf_lo(pv.y), bf_hi(pv.y), bf_lo(pv.z), bf_hi(pv.z), bf_lo(pv.w), bf_hi(pv.w)};
                const float nf[8] = {bf_lo(nx.x), bf_hi(nx.x), bf_lo(nx.y), bf_hi(nx.y), bf_lo(nx.z), bf_hi(nx.z), bf_lo(nx.w), bf_hi(nx.w)};
                float pre[8], res[8];
#pragma unroll
                for (int e = 0; e < 8; ++e) { pre[e] = w0[e] * pf[e] + w1[e] * ac[e] + w2[e] * nf[e] + bb[e]; res[e] = pre[e] * sigmoid_f(pre[e]) * uc[e]; }
                const bool edge0 = (r == 0), edge1 = (r == BM - 1);
                if (edge0 || edge1) {
                    const size_t ho = ((size_t)u.pm * 2 + (edge1 ? 1 : 0)) * dff + j0;
#pragma unroll
                    for (int q = 0; q < 2; ++q) { *(f32x4*)(HA + ho + 4 * q) = (f32x4){ac[4 * q], ac[4 * q + 1], ac[4 * q + 2], ac[4 * q + 3]};
                        *(f32x4*)(HP + ho + 4 * q) = (f32x4){pre[4 * q], pre[4 * q + 1], pre[4 * q + 2], pre[4 * q + 3]}; *(f32x4*)(HU + ho + 4 * q) = (f32x4){uc[4 * q], uc[4 * q + 1], uc[4 * q + 2], uc[4 * q + 3]}; }
                }
                if (!((edge0 && top_open) || (edge1 && bot_open))) {
                    u32x4 w; w.x = cvt_pk_bf16(res[0], res[1]); w.y = cvt_pk_bf16(res[2], res[3]); w.z = cvt_pk_bf16(res[4], res[5]); w.w = cvt_pk_bf16(res[6], res[7]);
                    *(u32x4*)(ACT + (size_t)(t0 + r) * dff + j0) = w; }
            }
    }
};
template <class Epi, class Sched, bool ALIGN_EPI = false, bool SP2 = false>
__device__ __forceinline__ void gemm_phase(PG8_LAS unsigned char* lds, const Gemm g, const Sched& S, const Epi& E, int tid_in) {
    int tid_ = tid_in; asm volatile("" : "+v"(tid_));
    const int tid = tid_, wid = __builtin_amdgcn_readfirstlane(tid >> 6), lane = tid & 63, wr = wid >> 2, wc = wid & 3, fr = lane & 15, fq = lane >> 4;
    const int K = g.K, nt = K / BK;
    unsigned voffA[2], voffB[2];
#pragma unroll
    for (int i = 0; i < 2; ++i) { int R, C; stage_rc(tid * 16 + i * 8192, R, C); const int Rb = Epi::PERM ? ((R & ~31) + perm32(R & 31)) : R;
        voffA[i] = (unsigned)(R * g.lda + C) * 2u; voffB[i] = (unsigned)(Rb * g.ldb + C) * 2u; }
    const size_t kstep = (size_t)(BK * 2);
    const size_t hstepA = (size_t)HALF * g.lda * 2, hstepB = (size_t)HALF * g.ldb * 2;
    const size_t tstepA = 2 * hstepA, tstepB = 2 * hstepB;
    const size_t sstep = (size_t)K * 2;
    const unsigned ldsw = (unsigned)wid * 1024u;
    const int aoff = lds_byte(wr * 64 + fr, fq * 8), boff = lds_byte(wc * 32 + fr, fq * 8);
#define PG8_SA(b, h) (((b) * 2 + (h)) * HTB)
#define PG8_SB(b, h) ((4 + (b) * 2 + (h)) * HTB)
#define PG8_STAGE(bufoff, gbase, voff) do { _Pragma("unroll") for (int _i = 0; _i < 2; ++_i) \
        __builtin_amdgcn_global_load_lds((const unsigned*)((const char*)(gbase) + (voff)[_i]), (PG8_LAS unsigned*)(lds + (bufoff) + ldsw + _i * 8192), 16, 0, 0); } while (0)
#define PG8_LDA(dst, b, h) do { _Pragma("unroll") for (int m = 0; m < 4; ++m) _Pragma("unroll") for (int k = 0; k < 2; ++k) dst[m][k] = *(const PG8_LAS bf16x8*)(lds + PG8_SA(b, h) + aoff + m * 2048 + k * 1024); } while (0)
#define PG8_LDB(dst, b, h) do { _Pragma("unroll") for (int n = 0; n < 2; ++n) _Pragma("unroll") for (int k = 0; k < 2; ++k) dst[n][k] = *(const PG8_LAS bf16x8*)(lds + PG8_SB(b, h) + boff + n * 2048 + k * 1024); } while (0)
#define PG8_MMA(ai, bj, At, Bt) do { __builtin_amdgcn_s_setprio(1); _Pragma("unroll") for (int m = 0; m < 4; ++m) _Pragma("unroll") for (int n = 0; n < 2; ++n) _Pragma("unroll") for (int k = 0; k < 2; ++k) \
        acc[ai][bj][m][n] = __builtin_amdgcn_mfma_f32_16x16x32_bf16(Bt[n][k], At[m][k], acc[ai][bj][m][n], 0, 0, 0); __builtin_amdgcn_s_setprio(0); } while (0)
#define PG8_WAIT_V(n) asm volatile("s_waitcnt vmcnt(" #n ")" ::: "memory")
#define PG8_WAIT_L(n) asm volatile("s_waitcnt lgkmcnt(" #n ")" ::: "memory")
#define PG8_BAR __builtin_amdgcn_s_barrier()
#define PG8_SCHED __builtin_amdgcn_sched_barrier(0)
    Unit cur, nxt; int ui = 0;
    if (!S.next(0, cur)) return;
    f32x4 acc[2][2][4][2];
#pragma unroll
    for (int a = 0; a < 2; ++a)
#pragma unroll
        for (int b = 0; b < 2; ++b)
#pragma unroll
            for (int m = 0; m < 4; ++m)
#pragma unroll
                for (int n = 0; n < 2; ++n) acc[a][b][m][n] = (f32x4){0.f, 0.f, 0.f, 0.f};
    bf16x8 At[4][2], B0[2][2], B1[2][2];
    const char* cA = (const char*)g.A + (size_t)cur.pm * tstepA + (size_t)cur.ks * sstep; const char* cB = (const char*)g.Bt + (size_t)cur.pn * tstepB + (size_t)cur.ks * sstep;
    S.a_ready(cur);
    if constexpr (SP2) {
        PG8_STAGE(PG8_SB(0, 0), cB, voffB); PG8_STAGE(PG8_SB(0, 1), cB + hstepB, voffB); PG8_STAGE(PG8_SA(0, 0), cA, voffA); PG8_STAGE(PG8_SA(0, 1), cA + hstepA, voffA);
        if (wr == 1) PG8_BAR;
        PG8_WAIT_V(2); PG8_BAR;
        PG8_STAGE(PG8_SB(1, 0), cB + kstep, voffB); PG8_STAGE(PG8_SA(1, 0), cA + kstep, voffA); PG8_STAGE(PG8_SB(1, 1), cB + hstepB + kstep, voffB);
        PG8_WAIT_V(6); PG8_BAR;
    } else {
        PG8_STAGE(PG8_SB(0, 0), cB, voffB); PG8_STAGE(PG8_SA(0, 0), cA, voffA); PG8_STAGE(PG8_SB(0, 1), cB + hstepB, voffB); PG8_STAGE(PG8_SA(0, 1), cA + hstepA, voffA);
        if (wr == 1) PG8_BAR;
        PG8_WAIT_V(4); PG8_BAR;
        PG8_STAGE(PG8_SB(1, 0), cB + kstep, voffB); PG8_STAGE(PG8_SA(1, 0), cA + kstep, voffA); PG8_STAGE(PG8_SB(1, 1), cB + hstepB + kstep, voffB);
        PG8_WAIT_V(6); PG8_BAR;
    }
    for (;;) {
        const bool has_next = S.next(ui + 1, nxt);
        const char* nA = has_next ? (const char*)g.A + (size_t)nxt.pm * tstepA + (size_t)nxt.ks * sstep : cA; const char* nB = has_next ? (const char*)g.Bt + (size_t)nxt.pn * tstepB + (size_t)nxt.ks * sstep : cB;
        for (int t = 0; t < nt; t += 2) {
            if constexpr (Epi::MIDK) { if (t == Epi::KB0) E.midk(acc, cur, 0, wr, wc, fr, fq); else if (t == Epi::KB1) E.midk(acc, cur, 1, wr, wc, fr, fq); }
            const bool last = (t == nt - 2);
            const char* a1 = cA + (size_t)(t + 1) * kstep;
            const char* a2 = last ? nA : cA + (size_t)(t + 2) * kstep; const char* b2 = last ? nB : cB + (size_t)(t + 2) * kstep;
            const char* a3 = a2 + kstep; const char* b3 = b2 + kstep;
            if (last && has_next) S.a_ready(nxt);
            if constexpr (SP2) {
            PG8_LDB(B0, 0, 0); PG8_LDB(B1, 0, 1); PG8_SCHED; PG8_LDA(At, 0, 0); PG8_STAGE(PG8_SA(1, 1), a1 + hstepA, voffA);
            PG8_WAIT_V(8); PG8_WAIT_L(0); PG8_BAR; PG8_MMA(0, 0, At, B0); PG8_MMA(0, 1, At, B1); PG8_BAR; PG8_SCHED;
            PG8_LDA(At, 0, 1); PG8_STAGE(PG8_SB(0, 0), b2, voffB); PG8_STAGE(PG8_SB(0, 1), b2 + hstepB, voffB); PG8_STAGE(PG8_SA(0, 0), a2, voffA);
            PG8_WAIT_V(8); PG8_WAIT_L(0); PG8_BAR; PG8_MMA(1, 0, At, B0); PG8_MMA(1, 1, At, B1); PG8_BAR; PG8_SCHED;
            PG8_LDB(B0, 1, 0); PG8_LDB(B1, 1, 1); PG8_SCHED; PG8_LDA(At, 1, 0); PG8_STAGE(PG8_SA(0, 1), a2 + hstepA, voffA);
            PG8_WAIT_V(8); PG8_WAIT_L(0); PG8_BAR; PG8_MMA(0, 0, At, B0); PG8_MMA(0, 1, At, B1); PG8_BAR; PG8_SCHED;
            PG8_LDA(At, 1, 1); PG8_STAGE(PG8_SB(1, 0), b3, voffB); PG8_STAGE(PG8_SB(1, 1), b3 + hstepB, voffB); PG8_STAGE(PG8_SA(1, 0), a3, voffA);
            PG8_WAIT_V(8); PG8_WAIT_L(0); PG8_BAR; PG8_MMA(1, 0, At, B0); PG8_MMA(1, 1, At, B1); PG8_BAR; PG8_SCHED;
            } else {
            PG8_LDB(B0, 0, 0); PG8_SCHED; PG8_LDA(At, 0, 0); PG8_STAGE(PG8_SA(1, 1), a1 + hstepA, voffA);
            PG8_WAIT_L(8); PG8_BAR; PG8_WAIT_L(0); PG8_MMA(0, 0, At, B0); PG8_BAR; PG8_SCHED;
            PG8_LDB(B1, 0, 1); PG8_STAGE(PG8_SB(0, 0), b2, voffB);
            PG8_BAR; PG8_WAIT_L(0); PG8_MMA(0, 1, At, B1); PG8_BAR;
            PG8_LDA(At, 0, 1); PG8_STAGE(PG8_SA(0, 0), a2, voffA);
            PG8_BAR; PG8_WAIT_L(0); PG8_MMA(1, 0, At, B0); PG8_BAR; PG8_SCHED;
            PG8_STAGE(PG8_SB(0, 1), b2 + hstepB, voffB);
            PG8_WAIT_V(6); PG8_BAR; PG8_MMA(1, 1, At, B1); PG8_BAR;
            PG8_LDB(B0, 1, 0); PG8_SCHED; PG8_LDA(At, 1, 0); PG8_STAGE(PG8_SA(0, 1), a2 + hstepA, voffA);
            PG8_WAIT_L(8); PG8_BAR; PG8_WAIT_L(0); PG8_MMA(0, 0, At, B0); PG8_BAR; PG8_SCHED;
            PG8_LDB(B1, 1, 1); PG8_STAGE(PG8_SB(1, 0), b3, voffB);
            PG8_BAR; PG8_WAIT_L(0); PG8_MMA(0, 1, At, B1); PG8_BAR;
            PG8_LDA(At, 1, 1); PG8_STAGE(PG8_SA(1, 0), a3, voffA);
            PG8_BAR; PG8_WAIT_L(0); PG8_MMA(1, 0, At, B0); PG8_BAR; PG8_SCHED;
            PG8_STAGE(PG8_SB(1, 1), b3 + hstepB, voffB);
            PG8_WAIT_V(6); PG8_BAR; PG8_MMA(1, 1, At, B1); PG8_BAR;
            }
        }
        if constexpr (ALIGN_EPI) { if (wr == 0) PG8_BAR; }
        if constexpr (!Epi::AFTER_DRAIN) { E(acc, cur, wr, wc, fr, fq); S.done(cur); }
        if (!has_next) break;
#pragma unroll
        for (int a = 0; a < 2; ++a)
#pragma unroll
            for (int b = 0; b < 2; ++b)
#pragma unroll
                for (int m = 0; m < 4; ++m)
#pragma unroll
                    for (int n = 0; n < 2; ++n) acc[a][b][m][n] = (f32x4){0.f, 0.f, 0.f, 0.f};
        cur = nxt; cA = nA; cB = nB; ++ui;
        if constexpr (ALIGN_EPI) { if (wr == 1) PG8_BAR; }
    }
    PG8_WAIT_V(0);
    if constexpr (!ALIGN_EPI) { if (wr == 0) PG8_BAR; }
    PG8_BAR;
    if constexpr (Epi::AFTER_DRAIN) { E.fused(acc, cur, wr, wc, fr, fq, lds, wid, lane); S.done(cur); }
#undef PG8_SA
#undef PG8_SB
#undef PG8_STAGE
#undef PG8_LDA
#undef PG8_LDB
#undef PG8_MMA
#undef PG8_WAIT_V
#undef PG8_WAIT_L
#undef PG8_BAR
#undef PG8_SCHED
}
}
#define HD __host__ __device__ __forceinline__
#if defined(__HIP_DEVICE_COMPILE__)
#define FFT_PIN() __builtin_amdgcn_sched_barrier(0)
#else
#define FFT_PIN() ((void)0)
#endif
typedef float cf2 __attribute__((ext_vector_type(2)));
HD cf2 cmul(cf2 a, cf2 b) { const cf2 b2 = {-b.y, b.x}; return a.xx * b + a.yy * b2; }
HD constexpr int PADI(int i) { return i + (i >> 5); }
constexpr int FFT_N = 8192, FFT_PADN = 8448;
HD constexpr float c32tab(int k) {
    constexpr float t[16] = {1.0f, 0.98078528040323043f, 0.92387953251128674f, 0.83146961230254524f, 0.70710678118654752f, 0.55557023301960218f, 0.38268343236508977f, 0.19509032201612825f,
                             0.0f, -0.19509032201612825f, -0.38268343236508977f, -0.55557023301960218f, -0.70710678118654752f, -0.83146961230254524f, -0.92387953251128674f, -0.98078528040323043f};
    return t[k];
}
HD constexpr float s32tab(int k) {
    constexpr float t[16] = {0.0f, 0.19509032201612825f, 0.38268343236508977f, 0.55557023301960218f, 0.70710678118654752f, 0.83146961230254524f, 0.92387953251128674f, 0.98078528040323043f,
                             1.0f, 0.98078528040323043f, 0.92387953251128674f, 0.83146961230254524f, 0.70710678118654752f, 0.55557023301960218f, 0.38268343236508977f, 0.19509032201612825f};
    return t[k];
}
HD constexpr int bitrev_c(int x, int bits) { int r = 0; for (int b = 0; b < bits; ++b) r |= ((x >> b) & 1) << (bits - 1 - b); return r; }
template <int R, int LOGR, int SIGN> HD void dft_reg(cf2 (&v)[R]) {
#pragma unroll
    for (int ls = LOGR - 1; ls >= 0; --ls) {
        const int span = 1 << ls;
#pragma unroll
        for (int i = 0; i < R; ++i) {
            if ((i & span) == 0) {
                const int k32 = (i & (span - 1)) * (R / (2 * span)) * (32 / R);
                const cf2 a = v[i], b = v[i + span]; v[i] = a + b; const cf2 d = a - b;
                if (k32 == 0) v[i + span] = d;
                else if (k32 == 8) { const cf2 m = {-(float)SIGN, (float)SIGN}; v[i + span] = d.yx * m; }
                else { const cf2 w1 = {c32tab(k32), (float)SIGN * s32tab(k32)}, w2 = {-(float)SIGN * s32tab(k32), c32tab(k32)}; v[i + span] = d.xx * w1 + d.yy * w2; }
            }
        }
    }
}
template <int R, int LOGR, int PM, bool TW> HD void fft_fwd_group(cf2* Xp, cf2 w) {
    cf2 v[R];
#pragma unroll
    for (int q = 0; q < R; ++q) v[q] = Xp[PM * q];
    dft_reg<R, LOGR, -1>(v);
    cf2 wp = {1.f, 0.f};
#pragma unroll
    for (int q = 0; q < R; ++q) { cf2 y = v[bitrev_c(q, LOGR)];
        if (TW && q > 0) { wp = cmul(wp, w); y = cmul(y, wp); }
        Xp[PM * q] = y; }
}
template <int R, int LOGR, int PM, bool TW> HD void fft_inv_group(cf2* Xp, cf2 w) {
    cf2 v[R];
    const cf2 wc = {w.x, -w.y}; cf2 wp = {1.f, 0.f};
#pragma unroll
    for (int q = 0; q < R; ++q) v[q] = Xp[PM * q];
    FFT_PIN();
#pragma unroll
    for (int q = 1; q < R; ++q) if (TW) { wp = cmul(wp, wc); v[q] = cmul(v[q], wp); }
    dft_reg<R, LOGR, +1>(v);
#pragma unroll
    for (int q = 0; q < R; ++q) Xp[PM * q] = v[bitrev_c(q, LOGR)];
}
HD int fft_pos_to_k(int p) { return (p >> 9) + 16 * ((p >> 5) & 15) + 256 * (p & 31); }
HD int fft_k_to_pos(int k) { return 512 * (k & 15) + 32 * ((k >> 4) & 15) + (k >> 8); }
HD int fft_conj_pos(int p) { return fft_k_to_pos((FFT_N - fft_pos_to_k(p)) & (FFT_N - 1)); }
HD void fft_fwd_passA(cf2* X, const cf2* TWL, int tid) { fft_fwd_group<16, 4, 528, true>(X + PADI(tid), TWL[tid]); }
HD void fft_fwd_passB(cf2* X, const cf2* TWL, int tid) { const int blk = tid >> 5, j = tid & 31; fft_fwd_group<16, 4, 33, true>(X + 528 * blk + j, TWL[16 * j]); }
HD void fft_fwd_passC(cf2* X, int g) { const cf2 w = {1.f, 0.f}; fft_fwd_group<32, 5, 1, false>(X + 33 * g, w); }
HD void fft_inv_passC(cf2* X, int g) { const cf2 w = {1.f, 0.f}; fft_inv_group<32, 5, 1, false>(X + 33 * g, w); }
HD void fft_inv_passB(cf2* X, const cf2* TWL, int tid) { const int blk = tid >> 5, j = tid & 31; fft_inv_group<16, 4, 33, true>(X + 528 * blk + j, TWL[16 * j]); }
HD void fft_inv_passA(cf2* X, const cf2* TWL, int tid) { fft_inv_group<16, 4, 528, true>(X + PADI(tid), TWL[tid]); }
template <class KP> HD void fft_passC_conv_half(cf2* X, const cf2 (&kk)[16], KP K, int g) {
    cf2* Xp = X + 33 * g; cf2 v[32], w[32];
#pragma unroll
    for (int q = 0; q < 32; ++q) v[q] = Xp[q];
    dft_reg<32, 5, -1>(v);
#pragma unroll
    for (int q = 0; q < 16; ++q) w[q] = cmul(v[bitrev_c(q, 5)], kk[q]);
#pragma unroll
    for (int q = 16; q < 32; ++q) { const cf2 k = {K[32 * g + q].x, K[32 * g + q].y}; w[q] = cmul(v[bitrev_c(q, 5)], k); }
    dft_reg<32, 5, +1>(w);
#pragma unroll
    for (int q = 0; q < 32; ++q) Xp[q] = w[bitrev_c(q, 5)];
}
HD void fft_passC_conv_regs(cf2* X, const cf2 (&kk)[32], int g) {
    cf2* Xp = X + 33 * g; cf2 v[32], w[32];
#pragma unroll
    for (int q = 0; q < 32; ++q) v[q] = Xp[q];
    dft_reg<32, 5, -1>(v);
#pragma unroll
    for (int q = 0; q < 32; ++q) w[q] = cmul(v[bitrev_c(q, 5)], kk[q]);
    dft_reg<32, 5, +1>(w);
#pragma unroll
    for (int q = 0; q < 32; ++q) Xp[q] = w[bitrev_c(q, 5)];
}
template <class KP> HD void fft_passC_conv(cf2* X, KP K, int g) {
    cf2* Xp = X + 33 * g; cf2 v[32], w[32];
#pragma unroll
    for (int q = 0; q < 32; ++q) v[q] = Xp[q];
    dft_reg<32, 5, -1>(v);
#pragma unroll
    for (int q = 0; q < 32; ++q) { const cf2 k = {K[32 * g + q].x, K[32 * g + q].y}; w[q] = cmul(v[bitrev_c(q, 5)], k); }
    dft_reg<32, 5, +1>(w);
#pragma unroll
    for (int q = 0; q < 32; ++q) Xp[q] = w[bitrev_c(q, 5)];
}
HD void fft_fwd_passA_zp(cf2* X, const cf2* TWL, int tid) {
    cf2* Xp = X + PADI(tid); cf2 v[16];
#pragma unroll
    for (int q = 0; q < 8; ++q) v[q] = Xp[528 * q];
#pragma unroll
    for (int q = 8; q < 16; ++q) { v[q].x = 0.f; v[q].y = 0.f; }
    dft_reg<16, 4, -1>(v);
    const cf2 w = TWL[tid]; cf2 wp = {1.f, 0.f};
#pragma unroll
    for (int q = 0; q < 16; ++q) { cf2 y = v[bitrev_c(q, 4)]; if (q > 0) { wp = cmul(wp, w); y = cmul(y, wp); } Xp[528 * q] = y; }
}
HD void fft_inv_passA_half(cf2* X, const cf2* TWL, int tid) {
    cf2* Xp = X + PADI(tid); cf2 v[16];
    const cf2 w = TWL[tid]; const cf2 wc = {w.x, -w.y}; cf2 wp = {1.f, 0.f};
#pragma unroll
    for (int q = 0; q < 16; ++q) v[q] = Xp[528 * q];
    FFT_PIN();
#pragma unroll
    for (int q = 1; q < 16; ++q) { wp = cmul(wp, wc); v[q] = cmul(v[q], wp); }
    dft_reg<16, 4, +1>(v);
#pragma unroll
    for (int q = 0; q < 8; ++q) Xp[528 * q] = v[bitrev_c(q, 4)];
}

template <int R, int LOGR, int PM, bool TW, int NLOAD> HD void fft_fwd_group2(cf2* Xp0, cf2* Xp1, cf2 w) {
    cf2 a[R], b[R];
#pragma unroll
    for (int q = 0; q < R; ++q) { if (q < NLOAD) { a[q] = Xp0[PM * q]; b[q] = Xp1[PM * q]; } else { a[q].x = 0.f; a[q].y = 0.f; b[q].x = 0.f; b[q].y = 0.f; } }
    FFT_PIN();
    dft_reg<R, LOGR, -1>(a); dft_reg<R, LOGR, -1>(b);
    cf2 wp = {1.f, 0.f};
#pragma unroll
    for (int q = 0; q < R; ++q) { cf2 ya = a[bitrev_c(q, LOGR)], yb = b[bitrev_c(q, LOGR)];
        if (TW && q > 0) { wp = cmul(wp, w); ya = cmul(ya, wp); yb = cmul(yb, wp); }
        Xp0[PM * q] = ya; Xp1[PM * q] = yb; }
}
template <int R, int LOGR, int PM, bool TW, int NSTORE> HD void fft_inv_group2(cf2* Xp0, cf2* Xp1, cf2 w) {
    cf2 a[R], b[R];
#pragma unroll
    for (int q = 0; q < R; ++q) { a[q] = Xp0[PM * q]; b[q] = Xp1[PM * q]; }
    FFT_PIN();
    const cf2 wc = {w.x, -w.y}; cf2 wp = {1.f, 0.f};
#pragma unroll
    for (int q = 1; q < R; ++q) if (TW) { wp = cmul(wp, wc); a[q] = cmul(a[q], wp); b[q] = cmul(b[q], wp); }
    dft_reg<R, LOGR, +1>(a); dft_reg<R, LOGR, +1>(b);
#pragma unroll
    for (int q = 0; q < NSTORE; ++q) { Xp0[PM * q] = a[bitrev_c(q, LOGR)]; Xp1[PM * q] = b[bitrev_c(q, LOGR)]; }
}
HD void fft_fwd_passA2(cf2* X0, cf2* X1, const cf2* TWL, int tid) { fft_fwd_group2<16, 4, 528, true, 16>(X0 + PADI(tid), X1 + PADI(tid), TWL[tid]); }
HD void fft_fwd_passA2_zp(cf2* X0, cf2* X1, const cf2* TWL, int tid) { fft_fwd_group2<16, 4, 528, true, 8>(X0 + PADI(tid), X1 + PADI(tid), TWL[tid]); }
HD void fft_fwd_passB2(cf2* X0, cf2* X1, const cf2* TWL, int tid) { const int blk = tid >> 5, j = tid & 31; fft_fwd_group2<16, 4, 33, true, 16>(X0 + 528 * blk + j, X1 + 528 * blk + j, TWL[16 * j]); }
HD void fft_inv_passB2(cf2* X0, cf2* X1, const cf2* TWL, int tid) { const int blk = tid >> 5, j = tid & 31; fft_inv_group2<16, 4, 33, true, 16>(X0 + 528 * blk + j, X1 + 528 * blk + j, TWL[16 * j]); }
HD void fft_inv_passA2(cf2* X0, cf2* X1, const cf2* TWL, int tid) { fft_inv_group2<16, 4, 528, true, 16>(X0 + PADI(tid), X1 + PADI(tid), TWL[tid]); }
HD void fft_inv_passA2_half(cf2* X0, cf2* X1, const cf2* TWL, int tid) { fft_inv_group2<16, 4, 528, true, 8>(X0 + PADI(tid), X1 + PADI(tid), TWL[tid]); }
constexpr int DM = 2048, NBATCH = 4, SEQ = 4096, DEPTH = 4, CTXL = 256, HDIM = 128;
constexpr int ML = NBATCH * SEQ, MC = NBATCH * CTXL, MT = ML + MC;
constexpr int HYW = 1024, NIN = 11776, DFF = 5632, NMOD = 6 * DM;
constexpr int NP = 7936, NU = 3840;
constexpr int P_NAK = 0, P_SWK = 512, P_NAQ = 768, P_SWQ = 1280, P_GATE = 1792;
constexpr int U_HY = 0, U_NAV = 3072, U_SWV = 3584;
constexpr float NORM_EPS = 1e-6f;
constexpr float HY_MIN_DECAY = -3.0701134573253945f, HY_MAX_DECAY = -15.350567286626973f;
constexpr int NWAVES = 8, NTHR = 512;

constexpr size_t MiB = 1u << 20;
constexpr size_t WS_CTL = 0, CTL_ZERO_BYTES = 64 * 1024;
constexpr size_t WS_MODV = 1 * MiB;
constexpr size_t WS_ROPE = 2 * MiB;
constexpr size_t WS_MODC = 2 * MiB + 64 * 1024;
constexpr size_t WS_A2 = 3 * MiB;
constexpr size_t WS_A2C = 7 * MiB;
constexpr size_t WS_KC = 8 * MiB, KC_BUF = 4 * MiB;
constexpr size_t WS_XC = 16 * MiB;
constexpr size_t WS_KSPEC = 24 * MiB, KSPEC_BUF = 64 * MiB;
constexpr size_t WS_WSET = 280 * MiB, WSET_BYTES = 128 * MiB;
constexpr size_t WO_WIN = 0, WO_WBR = 46 * MiB, WO_WOUT = 54 * MiB, WO_WUP = 62 * MiB, WO_WDN = 106 * MiB;
constexpr size_t WS_H = 536 * MiB;
constexpr size_t WS_MM = WS_H;
constexpr size_t WS_MIX = 604 * MiB;
constexpr size_t WS_Y = WS_MIX; constexpr int Y_NA = 1024, Y_SW = 1536;
constexpr size_t WS_ACT = 740 * MiB;
constexpr size_t WS_T1 = WS_ACT, WS_T2 = WS_ACT + 68 * MiB;
constexpr size_t WS_P = 927 * MiB;
constexpr size_t WS_UT = 1191 * MiB;
constexpr size_t WS_AU = WS_P;
constexpr size_t WS_HALO = 1319 * MiB, HALO_ONE = 4 * MiB;
constexpr size_t WS_XH = 152 * MiB;
constexpr size_t WS_END = 1331 * MiB;
static_assert(WS_P + (size_t)MT * NP * 2 <= WS_UT && WS_UT + (size_t)NU * MT * 2 <= WS_HALO && (size_t)68 * 2 * DFF * 4 <= HALO_ONE, "ws map");
static_assert(WS_KSPEC + 2 * KSPEC_BUF <= WS_XH && WS_XH + (size_t)MT * DM * 2 <= WS_WSET, "ws map 4");
static_assert(WS_ACT + (size_t)MT * DFF * 2 <= WS_P && WS_MIX + (size_t)MT * DM * 4 <= WS_ACT && WS_H + (size_t)MT * DM * 2 <= WS_MIX && WS_WSET + 2 * WSET_BYTES <= WS_H && WS_KSPEC + 2 * KSPEC_BUF <= WS_WSET, "ws map 2");
static_assert(WO_WDN + (size_t)DM * DFF * 2 <= WSET_BYTES && WS_Y + (size_t)MT * DM * 2 <= WS_MIX + (size_t)MT * DM * 4 && WS_T2 + (size_t)MT * DM * 2 <= WS_ACT + (size_t)MT * DFF * 2, "ws map 3");
constexpr int CW_TMO = 0, CW_CODE = 1, CW_BAR = 4096;

constexpr int LDS_BYTES = 147456;
constexpr int MISC_OFF = 143360;
constexpr int FFT_BUF_BYTES = FFT_PADN * 8;
constexpr int LDS_X0 = 0, LDS_X1 = FFT_BUF_BYTES, LDS_TW = 2 * FFT_BUF_BYTES;
constexpr int LDS_SM = LDS_TW + 4096;
static_assert(LDS_SM + 4096 <= MISC_OFF, "LDS map");

#define GAS __attribute__((address_space(1)))
#define LAS __attribute__((address_space(3)))
typedef unsigned short bf16;
typedef unsigned v4u __attribute__((ext_vector_type(4)));
typedef unsigned v2u __attribute__((ext_vector_type(2)));
typedef float f32x4 __attribute__((ext_vector_type(4)));
typedef float f32x2v __attribute__((ext_vector_type(2)));
typedef short bf16x8 __attribute__((ext_vector_type(8)));
typedef GAS unsigned gu32;
#define RLX_AGENT __ATOMIC_RELAXED, __HIP_MEMORY_SCOPE_AGENT
#define LDS_WAIT() asm volatile("s_waitcnt lgkmcnt(0)" ::: "memory")
#define VM_WAIT() asm volatile("s_waitcnt vmcnt(0)" ::: "memory")
__device__ __forceinline__ unsigned f2bf(float f) { unsigned u = __builtin_bit_cast(unsigned, f); return (u + 0x7fffu + ((u >> 16) & 1u)) >> 16; }
__device__ __forceinline__ unsigned pk2(float lo, float hi) { return pg8::cvt_pk_bf16(lo, hi); }
__device__ __forceinline__ float bf2f(bf16 b) { return __uint_as_float(((unsigned)b) << 16); }
__device__ __forceinline__ float blo(unsigned u) { return __uint_as_float(u << 16); }
__device__ __forceinline__ float bhi(unsigned u) { return __uint_as_float(u & 0xffff0000u); }
__device__ __forceinline__ float wave_sum(float v) {
#define WS_DPP(x, ctrl, rmask) __builtin_bit_cast(float, __builtin_amdgcn_update_dpp(0, __builtin_bit_cast(int, (x)), (ctrl), (rmask), 0xf, false))
    v += WS_DPP(v, 0xB1, 0xf);
    v += WS_DPP(v, 0x4E, 0xf);
    v += WS_DPP(v, 0x141, 0xf);
    v += WS_DPP(v, 0x140, 0xf);
    v += WS_DPP(v, 0x142, 0xa);
    v += WS_DPP(v, 0x143, 0xc);
#undef WS_DPP
    return __builtin_bit_cast(float, __builtin_amdgcn_readlane(__builtin_bit_cast(int, v), 63));
}
#define XB_TMO      128
#define XB_XCNT(j)  (256  + 64 * (j))
#define XB_XSUB(j)  (1280 + 64 * (j))
#define XB_XGEN(j)  (2304 + 64 * (j))
#define XB_TOP      3328
#define XB_TOPGEN   3392
#define XCD_BAR_WORDS 3456
#define XB_SPIN_CAP (1u << 18)

__device__ __forceinline__ unsigned xb_ld(unsigned* p)              { return __hip_atomic_load(p, __ATOMIC_RELAXED, __HIP_MEMORY_SCOPE_AGENT); }
__device__ __forceinline__ unsigned xb_add(unsigned* p, unsigned v) { return __hip_atomic_fetch_add(p, v, __ATOMIC_RELAXED, __HIP_MEMORY_SCOPE_AGENT); }
__device__ __forceinline__ unsigned xb_xcc_id() { return (unsigned)__builtin_amdgcn_s_getreg((3 << 11) | 20) & 0xFu; }
#define XB_SPIN(cond, bar) do { unsigned _sp = 0; while (cond) { \
    if ((++_sp & 255u) == 0u) { if (xb_ld(&(bar)[XB_TMO])) break; if (_sp > XB_SPIN_CAP) { atomicAdd(&(bar)[XB_TMO], 1u); break; } } } } while (0)

struct XcdBarrier {
    unsigned* bar; unsigned x;
    volatile LAS unsigned* st;
};

__device__ __forceinline__ XcdBarrier xcd_barrier_post(unsigned* bar, volatile LAS unsigned* st, int tid) {
    XcdBarrier b; b.bar = bar; b.x = xb_xcc_id(); b.st = st;
    if (tid == 0) (void)xb_add(&bar[XB_XCNT(b.x)], 1u);
    return b;
}
__device__ __forceinline__ void xcd_barrier_complete(unsigned* bar, unsigned x, unsigned& nloc, unsigned& nx) {
    const unsigned G = gridDim.x * gridDim.y * gridDim.z;
    unsigned sum, cnt, mine, sp = 0u;
    for (;;) {
        sum = 0u; cnt = 0u; mine = 0u;
#pragma unroll 1
        for (unsigned j = 0; j < 16; ++j) { const unsigned c = xb_ld(&bar[XB_XCNT(j)]); sum += c; cnt += (c > 0u) ? 1u : 0u; mine = (j == x) ? c : mine; }
        if (sum == G) break;
        __builtin_amdgcn_s_sleep(1);
        if ((++sp & 255u) == 0u) { if (xb_ld(&bar[XB_TMO])) break; if (sp > XB_SPIN_CAP) { atomicAdd(&bar[XB_TMO], 1u); break; } }
    }
    nloc = mine > 0u ? mine : 1u; nx = cnt > 0u ? cnt : 1u;
}

__device__ __forceinline__ void xcd_barrier(const XcdBarrier& b, int tid) {
    asm volatile("s_waitcnt vmcnt(0)" ::: "memory");
    __syncthreads();
    if (tid == 0) {
        unsigned* bar = b.bar;
        __builtin_amdgcn_s_waitcnt(0);
        unsigned nloc = b.st[0], nx = b.st[1];
        if (nloc == 0u) { xcd_barrier_complete(bar, b.x, nloc, nx); b.st[0] = nloc; b.st[1] = nx; }
        const unsigned old = xb_add(&bar[XB_XSUB(b.x)], 1u);
        const unsigned gen = old / nloc;
        if (old + 1u == (gen + 1u) * nloc) {
            __builtin_amdgcn_fence(__ATOMIC_RELEASE, "agent");
            asm volatile("s_waitcnt vmcnt(0)" ::: "memory");
            const unsigned og = xb_add(&bar[XB_TOP], 1u);
            const unsigned tg = og / nx;
            if (og + 1u == (tg + 1u) * nx) xb_add(&bar[XB_TOPGEN], 1u);
            else XB_SPIN(xb_ld(&bar[XB_TOPGEN]) == tg, bar);
            __builtin_amdgcn_fence(__ATOMIC_ACQUIRE, "agent");
            xb_add(&bar[XB_XGEN(b.x)], 1u);
            asm volatile("s_waitcnt vmcnt(0)" ::: "memory");
        } else {
            XB_SPIN(xb_ld(&bar[XB_XGEN(b.x)]) == gen, bar);
            __builtin_amdgcn_fence(__ATOMIC_ACQUIRE, "agent");
            asm volatile("s_waitcnt vmcnt(0)" ::: "memory");
        }
    }
    __syncthreads();
}
struct Frame {
    LAS unsigned char* lds;
    unsigned char* ldsg;
    volatile LAS unsigned* MISC;
    gu32* ctl;
    int tid, lane, wave, G, bid;
    unsigned char* ws;
    unsigned long long karg;
};
typedef const float* cfp_t;
__device__ __forceinline__ const float* INP(const Frame& F, int i) { const cfp_t p = ((const __attribute__((address_space(4))) cfp_t*)F.karg)[i]; return (const float*)(const GAS float*)p; }
__device__ __forceinline__ float* OUTP(const Frame& F) { const cfp_t p = ((const __attribute__((address_space(4))) cfp_t*)F.karg)[25]; return (float*)(GAS float*)p; }
enum InIdx { I_X = 0, I_C, I_CTX, I_CCTX, I_WMOD, I_BMOD, I_GAINS, I_WIN, I_HCW, I_HCB, I_HW1, I_HB1, I_HFREQ, I_HW2, I_HB2, I_HW3, I_HSKIP, I_RPB, I_SINK, I_WBR, I_WOUT, I_WUP, I_FCW, I_FCB, I_WDN };

typedef _Float16 h2v __attribute__((ext_vector_type(2)));
typedef _Float16 h4v __attribute__((ext_vector_type(4)));
typedef _Float16 h8v __attribute__((ext_vector_type(8)));
__device__ __forceinline__ unsigned pack_h2(float a, float b) { h2v h; h.x = (_Float16)a; h.y = (_Float16)b; return __builtin_bit_cast(unsigned, h); }
__device__ __forceinline__ void p0_modvec(Frame& F) {
    LAS float* sc = (LAS float*)(F.lds);
    LAS float* part = (LAS float*)(F.lds + 40960);
    float* modv = (float*)(F.ws + WS_MODV);
    if (F.bid < 192) {
        for (int i = F.tid; i < 5 * DM; i += NTHR) { const int r = i >> 11, k = i & 2047; const float x = r < 4 ? INP(F, I_C)[r * DM + k] : INP(F, I_CCTX)[k]; sc[i] = x / (1.0f + expf(-x)); }
        __syncthreads();
        for (int it = F.bid; it < 192; it += F.G) {
            const int l = it / 48, cg = it % 48;
            const float* W = INP(F, I_WMOD) + (size_t)l * DM * NMOD + cg * 256 + 4 * F.lane;
            float acc[5][4];
#pragma unroll
            for (int r = 0; r < 5; ++r)
#pragma unroll
                for (int j = 0; j < 4; ++j) acc[r][j] = 0.f;
#pragma unroll 8
            for (int i = 0; i < 256; ++i) { const int k = F.wave + 8 * i; const f32x4 w = __builtin_nontemporal_load((const f32x4*)(W + (size_t)k * NMOD));
#pragma unroll
                for (int r = 0; r < 5; ++r) { const float s = sc[r * DM + k];
#pragma unroll
                    for (int j = 0; j < 4; ++j) acc[r][j] += s * w[j]; } }
#pragma unroll
            for (int r = 0; r < 5; ++r)
#pragma unroll
                for (int j = 0; j < 4; ++j) part[(F.wave * 5 + r) * 256 + 4 * F.lane + j] = acc[r][j];
            __syncthreads();
            for (int o = F.tid; o < 1280; o += NTHR) { const int r = o >> 8, cc = o & 255; float s = 0.f;
#pragma unroll
                for (int w = 0; w < 8; ++w) s += part[(w * 5 + r) * 256 + cc];
                const int col = cg * 256 + cc; modv[(size_t)(l * 5 + r) * NMOD + col] = s + INP(F, I_BMOD)[l * NMOD + col]; }
            __syncthreads();
        }
    }
    if (F.bid == F.G - 1) {
        float2* rope = (float2*)(F.ws + WS_ROPE);
        for (int e = F.tid; e < 2048; e += NTHR) { const int pos = e >> 5, i = e & 31; const float inv = powf(10000.0f, -(float)(2 * i) / 64.0f); const float ang = (float)pos * inv; float s, c; sincosf(ang, &s, &c); rope[e] = make_float2(c, s); }
    }
}

__device__ __forceinline__ void load_row(const float* p, int lane, f32x4 (&v)[8]) {
#pragma unroll
    for (int j = 0; j < 8; ++j) v[j] = *(const f32x4*)(p + 4 * lane + 256 * j);
}
__device__ __forceinline__ float row_rstd(const f32x4 (&v)[8]) {
    float s = 0.f;
#pragma unroll
    for (int j = 0; j < 8; ++j) s += (v[j].x * v[j].x + v[j].y * v[j].y) + (v[j].z * v[j].z + v[j].w * v[j].w);
    s = wave_sum(s);
    return 1.0f / sqrtf(s * (1.0f / DM) + NORM_EPS);
}
__device__ __forceinline__ void store_h(bf16* hrow, int lane, const f32x4 (&x)[8], float rstd, const float* g, const float* shift, const float* scale) {
#pragma unroll
    for (int j = 0; j < 8; ++j) { const int col = 4 * lane + 256 * j;
        const f32x4 gg = *(const f32x4*)(g + col), sh = *(const f32x4*)(shift + col), sc = *(const f32x4*)(scale + col);
        const f32x4 y = (x[j] * rstd * gg) * (1.0f + sc) + sh;
        v2u o; o.x = pk2(y.x, y.y); o.y = pk2(y.z, y.w); *(v2u*)(hrow + col) = o; }
}
__device__ __forceinline__ int row_bidx(int m) { return m < ML ? (m >> 12) : 4; }
__device__ __forceinline__ float* xrow_ptr(Frame& F, int m) { return m < ML ? OUTP(F) + (size_t)m * DM : (float*)(F.ws + WS_XC) + (size_t)(m - ML) * DM; }
__device__ __forceinline__ const float* xin_ptr(Frame& F, int m) { return m < ML ? INP(F, I_X) + (size_t)m * DM : INP(F, I_CTX) + (size_t)(m - ML) * DM; }
__device__ __forceinline__ void rows_first(Frame& F) {
    const int gw = F.bid * NWAVES + F.wave, NGW = F.G * NWAVES;
    const float* modv = (const float*)(F.ws + WS_MODV); bf16* H = (bf16*)(F.ws + WS_H);
    for (int m = gw; m < MT; m += NGW) {
        f32x4 x[8]; load_row(xin_ptr(F, m), F.lane, x);
        const float rstd = row_rstd(x);
        const float* mv = modv + (size_t)(0 * 5 + row_bidx(m)) * NMOD;
        store_h(H + (size_t)m * DM, F.lane, x, rstd, INP(F, I_GAINS) + 0, mv + 0 * DM, mv + 1 * DM);
    }
}
__device__ __forceinline__ void p1_modcomb(Frame& F) {
    const float* modv = (const float*)(F.ws + WS_MODV); _Float16* mc = (_Float16*)(F.ws + WS_MODC); const float* gains = INP(F, I_GAINS);
    for (int i = F.bid * NTHR + F.tid; i < DEPTH * 5 * DM; i += F.G * NTHR) { const int lb = i >> 11, col = i & 2047, l = lb / 5;
        const float* mv = modv + (size_t)lb * NMOD + col; const float* g = gains + (size_t)l * 4 * DM + col; _Float16* o = mc + (size_t)lb * 6 * DM + col;
        o[0] = (_Float16)(mv[2 * DM] * g[1 * DM]); o[DM] = (_Float16)(g[2 * DM] * (1.0f + mv[4 * DM])); o[2 * DM] = (_Float16)mv[3 * DM];
        o[3 * DM] = (_Float16)(mv[5 * DM] * g[3 * DM]); o[4 * DM] = (_Float16)(g[0] * (1.0f + mv[1 * DM])); o[5 * DM] = (_Float16)mv[0]; }
}
__device__ __forceinline__ f32x4 ldh4(const _Float16* p) { const h4v h = *(const h4v*)p; return (f32x4){(float)h.x, (float)h.y, (float)h.z, (float)h.w}; }
__device__ __forceinline__ void load_row_h(const unsigned* p, int lane, f32x4 (&v)[8]) {
#pragma unroll
    for (int j = 0; j < 8; ++j) { const h4v h = *(const h4v*)(p + 2 * lane + 128 * j); v[j] = (f32x4){(float)h.x, (float)h.y, (float)h.z, (float)h.w}; }
}
__device__ __forceinline__ float clamp_h(float x) { return __builtin_amdgcn_fmed3f(x, -65000.0f, 65000.0f); }
__device__ __forceinline__ void rows_residual(Frame& F, int l, const float* SRC, int which, int mrows, bool x_from_input, bool x_to_output) {
    const int gw = F.bid * NWAVES + F.wave, NGW = F.G * NWAVES;
    const _Float16* mc = (const _Float16*)(F.ws + WS_MODC); bf16* H = (bf16*)(F.ws + WS_H);
    const bool has_h = (which == 0) || (l + 1 < DEPTH); const int lh = which == 0 ? l : l + 1;
    LAS float* lv = (LAS float*)F.lds;
    __syncthreads();
    for (int i = F.tid; i < 5 * 3 * (DM / 4); i += NTHR) { const int v = i / (DM / 4), c4 = i % (DM / 4), bi = v / 3, k = v % 3;
        const _Float16* src = (k == 0) ? mc + (size_t)((l * 5 + bi) * 6 + (which == 0 ? 0 : 3)) * DM : mc + (size_t)((lh * 5 + bi) * 6 + (which == 0 ? 1 : 4) + (k - 1)) * DM;
        h4v t = {(_Float16)0.f, (_Float16)0.f, (_Float16)0.f, (_Float16)0.f}; if (k == 0 || has_h) t = *(const h4v*)(src + 4 * c4);
        *(LAS f32x4*)(lv + (size_t)v * DM + 4 * c4) = (f32x4){(float)t.x, (float)t.y, (float)t.z, (float)t.w}; }
    __syncthreads();
    for (int m = gw; m < mrows; m += NGW) {
        const int bi = row_bidx(m);
        const LAS float* Ap = lv + (bi * 3) * DM + 4 * F.lane;
        f32x4 A[8];
#pragma unroll
        for (int j = 0; j < 8; ++j) A[j] = *(const LAS f32x4*)(Ap + 256 * j);
        f32x4 s[8];
        if (m < ML) { const bf16* sb = (const bf16*)SRC + (size_t)m * DM;
#pragma unroll
            for (int j = 0; j < 8; ++j) { const v2u r = *(const v2u*)(sb + 4 * F.lane + 256 * j); s[j] = (f32x4){blo(r.x), bhi(r.x), blo(r.y), bhi(r.y)}; } }
        else {
            const unsigned* sl = (const unsigned*)(F.ws + WS_UT) + (size_t)(m - ML) * (DM / 2); load_row_h(sl, F.lane, s);
            for (int k = 1; k < 4; ++k) { f32x4 t[8]; load_row_h(sl + (size_t)k * MC * (DM / 2), F.lane, t);
#pragma unroll
                for (int j = 0; j < 8; ++j) s[j] += t[j]; } }
        const float rs = row_rstd(s);
        unsigned* xh = (unsigned*)(F.ws + WS_XH) + (size_t)m * (DM / 2); f32x4 x[8];
        if (x_from_input) load_row(xin_ptr(F, m), F.lane, x); else load_row_h(xh, F.lane, x);
#pragma unroll
        for (int j = 0; j < 8; ++j) { const int col = 4 * F.lane + 256 * j;
            x[j] = x[j] + A[j] * (s[j] * rs);
            if (x_to_output) *(f32x4*)(OUTP(F) + (size_t)m * DM + col) = x[j];
            else { h4v o; o.x = (_Float16)clamp_h(x[j].x); o.y = (_Float16)clamp_h(x[j].y); o.z = (_Float16)clamp_h(x[j].z); o.w = (_Float16)clamp_h(x[j].w); *(h4v*)(xh + 2 * F.lane + 128 * j) = o; } }
        if (has_h) { const float rstd = row_rstd(x);
            const LAS float* Bp = lv + (bi * 3 + 1) * DM + 4 * F.lane; const LAS float* Cp = Bp + DM;
            bf16* hrow = H + (size_t)m * DM + 4 * F.lane;
#pragma unroll
            for (int j = 0; j < 8; ++j) { const f32x4 bb = *(const LAS f32x4*)(Bp + 256 * j), cc = *(const LAS f32x4*)(Cp + 256 * j); const f32x4 y = (x[j] * rstd) * bb + cc;
                v2u o; o.x = pk2(y.x, y.y); o.y = pk2(y.z, y.w); *(v2u*)(hrow + 256 * j) = o; } }
    }
}

__device__ __forceinline__ void tr_block(const float* W, int ldw, int K, int k0, int n_src0, bf16* WT, int n_dst0, LAS float* scr, int lane) {
#pragma unroll 8
    for (int i = 0; i < 32; ++i) { const int kk = 2 * i + (lane >> 5); scr[kk * 33 + (lane & 31)] = __builtin_nontemporal_load(W + (size_t)(k0 + kk) * ldw + n_src0 + (lane & 31)); }
    LDS_WAIT(); asm volatile("" ::: "memory");
    const int c = lane & 7;
#pragma unroll
    for (int j = 0; j < 4; ++j) { const int n = (lane >> 3) + 8 * j; const LAS float* s = scr + (8 * c) * 33 + n;
        v4u o; o.x = pk2(s[0 * 33], s[1 * 33]); o.y = pk2(s[2 * 33], s[3 * 33]); o.z = pk2(s[4 * 33], s[5 * 33]); o.w = pk2(s[6 * 33], s[7 * 33]);
        *(v4u*)(WT + (size_t)(n_dst0 + n) * K + k0 + 8 * c) = o; }
    LDS_WAIT(); asm volatile("" ::: "memory");
}
__device__ __forceinline__ int win_src_col(int d) {
    if (d < 512) return d;
    if (d < 768) return 1024 + (d - 512);
    if (d < 1280) return 4608 + (d - 768);
    if (d < 1792) return 5120 + (d - 1280);
    if (d < 7936) return 5632 + (d - 1792);
    if (d < 11008) return 1536 + (d - 7936);
    if (d < 11520) return 512 + (d - 11008);
    return 1280 + (d - 11520);
}
__device__ __forceinline__ void p1_weights(Frame& F, int l, int wset) {
    LAS float* scr = (LAS float*)(F.lds + F.wave * 8704);
    const int gw = F.bid * NWAVES + F.wave, NGW = F.G * NWAVES;
    constexpr int I_A = 368 * 32, I_B = 2048, I_C2 = 2048, I_D = 352 * 32, I_E = 64 * 88, NIT = I_A + I_B + I_C2 + I_D + I_E;
    unsigned char* wb = F.ws + WS_WSET + (size_t)wset * WSET_BYTES;
    bf16* WIN = (bf16*)(wb + WO_WIN); bf16* WBR = (bf16*)(wb + WO_WBR); bf16* WOUT = (bf16*)(wb + WO_WOUT); bf16* WUP = (bf16*)(wb + WO_WUP); bf16* WDN = (bf16*)(wb + WO_WDN);
    for (int it = gw; it < NIT; it += NGW) {
        int r = it;
        if (r < I_A) { const int nb = r / 32, kb = r % 32; tr_block(INP(F, I_WIN) + (size_t)l * DM * NIN, NIN, DM, 64 * kb, win_src_col(32 * nb), WIN, 32 * nb, scr, F.lane); continue; } r -= I_A;
        if (r < I_B) { const int nb = r / 32, kb = r % 32; tr_block(INP(F, I_WBR) + (size_t)l * DM * DM, DM, DM, 64 * kb, 32 * nb, WBR, 32 * nb, scr, F.lane); continue; } r -= I_B;
        if (r < I_C2) { const int nb = r / 32, kb = r % 32; tr_block(INP(F, I_WOUT) + (size_t)l * DM * DM, DM, DM, 64 * kb, 32 * nb, WOUT, 32 * nb, scr, F.lane); continue; } r -= I_C2;
        if (r < I_D) { const int nb = r / 32, kb = r % 32, d = 32 * nb, tl = d >> 8, wi = d & 255;
            tr_block(INP(F, I_WUP) + (size_t)l * DM * 2 * DFF, 2 * DFF, DM, 64 * kb, wi < 128 ? 128 * tl + wi : DFF + 128 * tl + (wi - 128), WUP, d, scr, F.lane); continue; } r -= I_D;
        { const int nb = r / 88, kb = r % 88; tr_block(INP(F, I_WDN) + (size_t)l * DFF * DM, DM, DFF, 64 * kb, 32 * nb, WDN, 32 * nb, scr, F.lane); }
    }
}
__device__ __forceinline__ void p0_filter_mlp(Frame& F) {
    const int gw = F.bid * NWAVES + F.wave, NGW = F.G * NWAVES, j = F.lane;
    for (int it = gw; it < DEPTH * 4352; it += NGW) {
        const int l = it / 4352, pos = it % 4352;
        const float* w1 = INP(F, I_HW1) + (size_t)l * 33 * 64; const float* b1 = INP(F, I_HB1) + l * 64; const float* fr = INP(F, I_HFREQ) + l * 128;
        const float* w2 = INP(F, I_HW2) + (size_t)l * 64 * 64; const float* b2 = INP(F, I_HB2) + l * 64;
        float* A2 = (float*)(F.ws + WS_A2) + (size_t)l * 4096 * 64; float* A2C = (float*)(F.ws + WS_A2C) + (size_t)l * 256 * 64;
        const int n = pos < 4096 ? 4096 : 256, i = pos < 4096 ? pos : pos - 4096;
        const float t = (float)i / (float)(n - 1), w = (6.283185307179586f / (float)n) * (float)i;
        float z = 0.f;
        if (j == 0) z = t;
        else if (j <= 16) { const float fb = 1e-4f + (float)(j - 1) * ((15.0f - 1e-4f) / 15.0f); z = cosf(fb * w); }
        else if (j <= 32) { const float fb = 1e-4f + (float)(j - 17) * ((15.0f - 1e-4f) / 15.0f); z = -sinf(fb * w); }
        float acc = b1[j];
#pragma unroll
        for (int f = 0; f < 33; ++f) acc += __shfl(z, f) * w1[f * 64 + j];
        const float a1 = sinf(fr[j] * acc);
        float acc2 = b2[j];
#pragma unroll 16
        for (int ii = 0; ii < 64; ++ii) acc2 += __shfl(a1, ii) * w2[ii * 64 + j];
        const float a2 = sinf(fr[64 + j] * acc2);
        if (pos < 4096) ((_Float16*)A2)[(size_t)pos * 64 + j] = (_Float16)a2;
        else A2C[(size_t)i * 64 + j] = a2;
    }
}

__device__ __forceinline__ void fft_twiddles(Frame& F) {
    cf2* TW = (cf2*)(F.ldsg + LDS_TW);
    float s, c; sincospif(-(float)F.tid * (1.0f / 4096.0f), &s, &c); cf2 w; w.x = c; w.y = s; TW[F.tid] = w;
}
template <int NBUF> __device__ __forceinline__ void fft_forward(Frame& F) {
    cf2* X0 = (cf2*)(F.ldsg + LDS_X0); cf2* X1 = (cf2*)(F.ldsg + LDS_X1); const cf2* TW = (const cf2*)(F.ldsg + LDS_TW);
    __syncthreads();
    if (NBUF == 2) fft_fwd_passA2(X0, X1, TW, F.tid); else fft_fwd_passA(X0, TW, F.tid);
    __syncthreads();
    if (NBUF == 2) fft_fwd_passB2(X0, X1, TW, F.tid); else fft_fwd_passB(X0, TW, F.tid);
    __syncthreads();
    if (NBUF == 2) { fft_fwd_passC(F.tid < 256 ? X0 : X1, F.tid & 255); } else { if (F.tid < 256) fft_fwd_passC(X0, F.tid); }
    __syncthreads();
}
template <int NBUF> __device__ __forceinline__ void fft_inverse(Frame& F) {
    cf2* X0 = (cf2*)(F.ldsg + LDS_X0); cf2* X1 = (cf2*)(F.ldsg + LDS_X1); const cf2* TW = (const cf2*)(F.ldsg + LDS_TW);
    __syncthreads();
    if (NBUF == 2) { fft_inv_passC(F.tid < 256 ? X0 : X1, F.tid & 255); } else { if (F.tid < 256) fft_inv_passC(X0, F.tid); }
    __syncthreads();
    fft_inv_passB(X0, TW, F.tid); if (NBUF == 2) fft_inv_passB(X1, TW, F.tid);
    __syncthreads();
    fft_inv_passA(X0, TW, F.tid); if (NBUF == 2) fft_inv_passA(X1, TW, F.tid);
    __syncthreads();
}

__device__ __forceinline__ void filter_pair(Frame& F, int l, int c0, int buf) {
    asm volatile("" : "+v"(F.tid)); F.lane = F.tid & 63;
    cf2* X0 = (cf2*)(F.ldsg + LDS_X0); cf2* X1 = (cf2*)(F.ldsg + LDS_X1);
    LAS float* XF0 = (LAS float*)(F.lds + LDS_X0); LAS float* XF1 = (LAS float*)(F.lds + LDS_X1);
    LAS float* W3S = (LAS float*)(F.lds + LDS_SM);
    LAS float* RED = (LAS float*)(F.lds + LDS_SM + 2048);
    const float* w3 = INP(F, I_HW3) + (size_t)l * 64 * 4096;
    const float* A2 = (const float*)(F.ws + WS_A2) + (size_t)l * 4096 * 64; const float* A2C = (const float*)(F.ws + WS_A2C) + (size_t)l * 256 * 64;
    const int lane = F.lane, n = lane & 15, q4 = lane >> 4;
    __syncthreads();
    { const int e8 = F.tid >> 6, kk = F.tid & 63; W3S[e8 * 64 + kk] = w3[(size_t)kk * 4096 + ((e8 >> 1) & 1) * 2048 + (e8 & 1) * 1024 + c0 + (e8 >> 2)]; }
    if (F.tid == 0) { cf2 zz; zz.x = 0.f; zz.y = 0.f; X0[PADI(4096)] = zz; X1[PADI(4096)] = zz; }
    const int n7 = n & 7; const int colb = ((n7 >> 1) & 1) * 2048 + (n7 & 1) * 1024 + c0 + ((n7 >> 2) & 1);
    h8v bfr[2];
#pragma unroll
    for (int s = 0; s < 2; ++s) {
#pragma unroll
        for (int j = 0; j < 8; ++j) bfr[s][j] = (_Float16)w3[(size_t)(32 * s + 8 * q4 + j) * 4096 + colb]; }
    const float dstep = (HY_MAX_DECAY - HY_MIN_DECAY) / 2047.0f;
    const int ch = (n7 >> 2) & 1, ord = n7 & 1, dir = (n7 >> 1) & 1; const bool up = n >= 8;
    const float del = fabsf(HY_MIN_DECAY + (float)(ord * 1024 + c0 + ch) * dstep);
    LAS float* XF = ch ? XF1 : XF0;
    float asum = 0.f;
    const float cdec = del * (1.4426950408889634f / 4095.0f);
    float dcur = __builtin_amdgcn_exp2f(-(float)(16 * F.wave + 4 * q4 + (up ? 2 : 0)) * cdec); const float r1 = __builtin_amdgcn_exp2f(-cdec), r128 = __builtin_amdgcn_exp2f(-128.0f * cdec);
#pragma unroll 4
    for (int i = 0; i < 32; ++i) {
        const int pos0 = 16 * (F.wave + 8 * i);
        const _Float16* aph = (const _Float16*)A2 + (size_t)(pos0 + n) * 64 + 8 * q4;
        f32x4 acc = (f32x4){0.f, 0.f, 0.f, 0.f};
#pragma unroll
        for (int s = 0; s < 2; ++s) { const h8v ah = *(const h8v*)(aph + 32 * s); acc = __builtin_amdgcn_mfma_f32_16x16x32_f16(ah, bfr[s], acc, 0, 0, 0); }
        {
            const float av[2] = {up ? acc[2] : acc[0], up ? acc[3] : acc[1]};
#pragma unroll
            for (int rr = 0; rr < 2; ++rr) { const int pos = pos0 + 4 * q4 + (up ? 2 : 0) + rr; const float val = av[rr] * (rr == 0 ? dcur : dcur * r1);
                const bool bad = (dir != 0) && (pos == 0); const int idx = bad ? 4096 : (dir == 0 ? pos : 8192 - pos); const float vs = bad ? 0.f : val;
                asum += fabsf(vs); XF[2 * PADI(idx) + ord] = vs; }
            dcur *= r128;
        }
    }
    asum += __shfl_xor(asum, 16); asum += __shfl_xor(asum, 32); asum += __shfl_xor(asum, 2); asum += __shfl_xor(asum, 8);
    if (q4 == 0 && n < 8 && dir == 0) RED[F.wave * 4 + ch * 2 + ord] = asum;
    __syncthreads();
    float tot[4];
#pragma unroll
    for (int e = 0; e < 4; ++e) { float t = 0.f;
#pragma unroll
        for (int w = 0; w < 8; ++w) t += RED[w * 4 + e];
        tot[e] = 1.0f / t; }
    cf2* Xa = X0 + PADI(F.tid); cf2* Xb = X1 + PADI(F.tid);
    const float h0 = 0.5f * tot[0], h1 = 0.5f * tot[1], h2 = 0.5f * tot[2], h3 = 0.5f * tot[3];
    fft_forward<2>(F);
    unsigned* KS = (unsigned*)(F.ws + WS_KSPEC + (size_t)buf * KSPEC_BUF) + (size_t)c0 * 2 * 8192 + F.tid;
#pragma unroll 2
    for (int i = 0; i < 16; ++i) { const int p = F.tid + 512 * i, pb = PADI(fft_conj_pos(p));
        const cf2 f = Xa[528 * i], g = X0[pb], f2 = Xb[528 * i], g2 = X1[pb];
        f32x2v k0, k1;
        k0.x = h0 * (f.x + g.x); k0.y = h0 * (f.y - g.y); k1.x = h1 * (f.y + g.y); k1.y = -h1 * (f.x - g.x);
        KS[512 * i] = pack_h2(k0.x, k0.y); KS[8192 + 512 * i] = pack_h2(k1.x, k1.y);
        k0.x = h2 * (f2.x + g2.x); k0.y = h2 * (f2.y - g2.y); k1.x = h3 * (f2.y + g2.y); k1.y = -h3 * (f2.x - g2.x);
        KS[16384 + 512 * i] = pack_h2(k0.x, k0.y); KS[16384 + 8192 + 512 * i] = pack_h2(k1.x, k1.y); }
    if (l + 1 < DEPTH) { const int cc = F.tid >> 8, pos = F.tid & 255; const f32x4* ar = (const f32x4*)(A2C + (size_t)pos * 64);
      const LAS float* W = W3S + cc * 256;
      float h0 = 0.f, h1 = 0.f, h2 = 0.f, h3 = 0.f;
#pragma unroll 4
      for (int q = 0; q < 16; ++q) { const f32x4 a = ar[q];
          const f32x4 u0 = *(const LAS f32x4*)(W + 0 * 64 + 4 * q), u1 = *(const LAS f32x4*)(W + 1 * 64 + 4 * q), u2 = *(const LAS f32x4*)(W + 2 * 64 + 4 * q), u3 = *(const LAS f32x4*)(W + 3 * 64 + 4 * q);
          h0 += (a.x * u0.x + a.y * u0.y) + (a.z * u0.z + a.w * u0.w); h1 += (a.x * u1.x + a.y * u1.y) + (a.z * u1.z + a.w * u1.w);
          h2 += (a.x * u2.x + a.y * u2.y) + (a.z * u2.z + a.w * u2.w); h3 += (a.x * u3.x + a.y * u3.y) + (a.z * u3.z + a.w * u3.w); }
      const float del0 = fabsf(HY_MIN_DECAY + (float)(c0 + cc) * dstep), del1 = fabsf(HY_MIN_DECAY + (float)(1024 + c0 + cc) * dstep);
      const float t = (float)pos * (1.0f / 255.0f), d0 = __builtin_amdgcn_exp2f(-t * del0 * 1.4426950408889634f), d1 = __builtin_amdgcn_exp2f(-t * del1 * 1.4426950408889634f);
      const float f0 = h0 * d0, f1 = h1 * d1, b0 = h2 * d0, b1 = h3 * d1;
      float c0s = fabsf(f0), c1s = fabsf(f1); if (pos >= 1) { c0s += fabsf(b0); c1s += fabsf(b1); }
      c0s = wave_sum(c0s); c1s = wave_sum(c1s);
      __syncthreads();
      if (F.lane == 0) { RED[F.wave * 2] = c0s; RED[F.wave * 2 + 1] = c1s; }
      __syncthreads();
      float u0 = 0.f, u1 = 0.f;
#pragma unroll
      for (int w = 0; w < 4; ++w) { u0 += RED[(4 * cc + w) * 2]; u1 += RED[(4 * cc + w) * 2 + 1]; }
      const float q0 = 1.0f / u0, q1 = 1.0f / u1;
      LAS float* KCS = XF0 + cc * 1024;
      KCS[pos] = f0 * q0; KCS[512 + pos] = f1 * q1;
      if (pos >= 1) { KCS[512 - pos] = b0 * q0; KCS[512 + 512 - pos] = b1 * q1; } else { KCS[256] = 0.f; KCS[512 + 256] = 0.f; }
      __syncthreads();
      float* KC = (float*)(F.ws + WS_KC + (size_t)buf * KC_BUF);
#pragma unroll
      for (int e = 0; e < 4; ++e) { const int idx = F.tid + 512 * e, c2 = idx >> 10, o2 = (idx >> 9) & 1, d = idx & 511; KC[(size_t)(o2 * 1024 + c0 + c2) * 512 + d] = XF0[idx]; }
      __syncthreads();
    }
}

__device__ __forceinline__ float conv3_at(const bf16* u, int t, int n, float w0, float w1, float w2, float bias) {
    const float cur = bf2f(u[t]); const float pv = bf2f(u[t - 1]), nv = bf2f(u[t + 1]);
    const float prv = t > 0 ? pv : 0.f; const float nxt = t < n - 1 ? nv : 0.f;
    return w0 * prv + w1 * cur + w2 * nxt + bias;
}
struct Raw8 { v4u r; float prv, nxt; };
__device__ __forceinline__ Raw8 load_raw8(const bf16* seq, int tid) {
    Raw8 x; const bf16* p = seq + 8 * tid; x.r = *(const v4u*)p;
    const float pv = bf2f(p[-1]), nv = bf2f(p[8]);
    x.prv = tid > 0 ? pv : 0.f; x.nxt = tid < 511 ? nv : 0.f; return x;
}
__device__ __forceinline__ void conv8(const Raw8& x, float w0, float w1, float w2, float bias, float (&o)[8]) {
    float e[10]; e[0] = x.prv; e[9] = x.nxt;
    e[1] = blo(x.r.x); e[2] = bhi(x.r.x); e[3] = blo(x.r.y); e[4] = bhi(x.r.y); e[5] = blo(x.r.z); e[6] = bhi(x.r.z); e[7] = blo(x.r.w); e[8] = bhi(x.r.w);
#pragma unroll
    for (int j = 0; j < 8; ++j) o[j] = w0 * e[j] + w1 * e[j + 1] + w2 * e[j + 2] + bias;
}
__device__ __forceinline__ void fft_passC_conv_h2(cf2* X, const unsigned (&kp)[32], int g) {
    cf2* Xp = X + 33 * g; cf2 v[32], w[32];
#pragma unroll
    for (int q = 0; q < 32; ++q) v[q] = Xp[q];
    dft_reg<32, 5, -1>(v);
#pragma unroll
    for (int q = 0; q < 32; ++q) { const h2v h = __builtin_bit_cast(h2v, kp[q]); const cf2 k = {(float)h.x, (float)h.y}; w[q] = cmul(v[bitrev_c(q, 5)], k); }
    dft_reg<32, 5, +1>(w);
#pragma unroll
    for (int q = 0; q < 32; ++q) Xp[q] = w[bitrev_c(q, 5)];
}
__device__ __forceinline__ void fft_conv2(Frame& F, const unsigned* K) {
    cf2* X0 = (cf2*)(F.ldsg + LDS_X0); cf2* X1 = (cf2*)(F.ldsg + LDS_X1); const cf2* TW = (const cf2*)(F.ldsg + LDS_TW);
    __syncthreads();
    fft_fwd_passA2_zp(X0, X1, TW, F.tid);
    __syncthreads();
    const int gC = 32 * F.wave + (F.lane & 31);
    unsigned kp[32];
    { const v4u* Kp = (const v4u*)(K + 32 * gC);
#pragma unroll
      for (int q = 0; q < 8; ++q) { const v4u t = Kp[q]; kp[4 * q] = t.x; kp[4 * q + 1] = t.y; kp[4 * q + 2] = t.z; kp[4 * q + 3] = t.w; } }
    FFT_PIN();
    fft_fwd_passB2(X0, X1, TW, F.tid);
    asm volatile("s_waitcnt lgkmcnt(0)" ::: "memory"); __builtin_amdgcn_wave_barrier();
    fft_passC_conv_h2(F.lane < 32 ? X0 : X1, kp, gC);
    asm volatile("s_waitcnt lgkmcnt(0)" ::: "memory"); __builtin_amdgcn_wave_barrier();
    fft_inv_passB2(X0, X1, TW, F.tid);
    __syncthreads();
    fft_inv_passA2_half(X0, X1, TW, F.tid);
    __syncthreads();
}
__device__ __forceinline__ void hyena_pair(Frame& F, int l, int c0, int buf, bool with_ctx) {
    cf2* X0 = (cf2*)(F.ldsg + LDS_X0); cf2* X1 = (cf2*)(F.ldsg + LDS_X1);
    const bf16* UT = (const bf16*)(F.ws + WS_UT);
    const float* cw = INP(F, I_HCW) + (size_t)l * 3 * 3072; const float* cb = INP(F, I_HCB) + (size_t)l * 3072;
    bf16* YH = (bf16*)(F.ws + WS_Y);
    const float* KC = (const float*)(F.ws + WS_KC + (size_t)buf * KC_BUF);
    unsigned op[4][4]; unsigned opc[2] = {0u, 0u};
#pragma unroll
    for (int b = 0; b < 4; ++b)
#pragma unroll
        for (int j = 0; j < 4; ++j) op[b][j] = 0u;
#pragma unroll 1
    for (int which = 0; which < 2; ++which) {
        asm volatile("" : "+v"(F.tid)); F.lane = F.tid & 63;
        const int c = c0 + which;
        const bf16* uv = UT + (size_t)(U_HY + c) * MT; const bf16* u1 = UT + (size_t)(U_HY + 1024 + c) * MT; const bf16* u2 = UT + (size_t)(U_HY + 2048 + c) * MT;
        const Raw8 r0 = load_raw8(uv + 0 * SEQ, F.tid), r1 = load_raw8(uv + 1 * SEQ, F.tid), r2 = load_raw8(uv + 2 * SEQ, F.tid), r3 = load_raw8(uv + 3 * SEQ, F.tid);
        const float vw0 = cw[c], vw1 = cw[3072 + c], vw2 = cw[6144 + c], vb = cb[c];
        const float aw0 = cw[1024 + c], aw1 = cw[3072 + 1024 + c], aw2 = cw[6144 + 1024 + c], ab = cb[1024 + c];
        const float bw0 = cw[2048 + c], bw1 = cw[3072 + 2048 + c], bw2 = cw[6144 + 2048 + c], bb = cb[2048 + c];
        const float sk0 = INP(F, I_HSKIP)[(size_t)l * 2048 + c], sk1 = INP(F, I_HSKIP)[(size_t)l * 2048 + 1024 + c];
        const unsigned* K0 = (const unsigned*)(F.ws + WS_KSPEC + (size_t)buf * KSPEC_BUF) + (size_t)c * 2 * 8192; const unsigned* K1 = K0 + 8192;
        const cf2 zero = {0.f, 0.f};
        cf2* Xa = X0 + PADI(8 * F.tid); cf2* Xb = X1 + PADI(8 * F.tid);
        FFT_PIN();
        __syncthreads();
        float v[4][8];
        { conv8(r0, vw0, vw1, vw2, vb, v[0]); conv8(r1, vw0, vw1, vw2, vb, v[1]); conv8(r2, vw0, vw1, vw2, vb, v[2]); conv8(r3, vw0, vw1, vw2, vb, v[3]); }
#pragma unroll
        for (int j = 0; j < 8; ++j) { cf2 a, b; a.x = v[0][j]; a.y = v[1][j]; b.x = v[2][j]; b.y = v[3][j]; Xa[j] = a; Xb[j] = b; }
        Raw8 xr[4];
#pragma unroll
        for (int b = 0; b < 4; ++b) xr[b] = load_raw8(u1 + b * SEQ, F.tid);
        fft_conv2(F, K0);
        float z[4][8];
        { float x1c[4][8];
#pragma unroll
          for (int b = 0; b < 4; ++b) conv8(xr[b], aw0, aw1, aw2, ab, x1c[b]);
#pragma unroll
          for (int j = 0; j < 8; ++j) { const cf2 ya = Xa[j], yb = Xb[j];
              z[0][j] = x1c[0][j] * (ya.x * (1.0f / 8192.0f) + sk0 * v[0][j]); z[1][j] = x1c[1][j] * (ya.y * (1.0f / 8192.0f) + sk0 * v[1][j]);
              z[2][j] = x1c[2][j] * (yb.x * (1.0f / 8192.0f) + sk0 * v[2][j]); z[3][j] = x1c[3][j] * (yb.y * (1.0f / 8192.0f) + sk0 * v[3][j]);
              cf2 a, b; a.x = z[0][j]; a.y = z[1][j]; b.x = z[2][j]; b.y = z[3][j]; Xa[j] = a; Xb[j] = b; } }
#pragma unroll
        for (int b = 0; b < 4; ++b) xr[b] = load_raw8(u2 + b * SEQ, F.tid);
        fft_conv2(F, K1);
        const int t = F.tid & 255, hf = F.tid >> 8, b0 = 2 * hf;
        const float kf0 = KC[(size_t)(0 * 1024 + c) * 512 + F.tid], kf1 = KC[(size_t)(1 * 1024 + c) * 512 + F.tid];
        float cv[2], cx1[2], cx2[2];
#pragma unroll
        for (int e = 0; e < 2; ++e) { const int so = ML + (b0 + e) * CTXL; cv[e] = conv3_at(uv + so, t, CTXL, vw0, vw1, vw2, vb); cx1[e] = conv3_at(u1 + so, t, CTXL, aw0, aw1, aw2, ab); cx2[e] = conv3_at(u2 + so, t, CTXL, bw0, bw1, bw2, bb); }
        { float x2c[4][8];
#pragma unroll
          for (int b = 0; b < 4; ++b) conv8(xr[b], bw0, bw1, bw2, bb, x2c[b]);
#pragma unroll
          for (int j = 0; j < 8; ++j) { const cf2 ya = Xa[j], yb = Xb[j];
              const float o0 = x2c[0][j] * (ya.x * (1.0f / 8192.0f) + sk1 * z[0][j]), o1 = x2c[1][j] * (ya.y * (1.0f / 8192.0f) + sk1 * z[1][j]);
              const float o2 = x2c[2][j] * (yb.x * (1.0f / 8192.0f) + sk1 * z[2][j]), o3 = x2c[3][j] * (yb.y * (1.0f / 8192.0f) + sk1 * z[3][j]);
              if (which == 0) { const int sh = (j >> 2) * 16; op[0][j & 3] |= f2bf(o0) << sh; op[1][j & 3] |= f2bf(o1) << sh; op[2][j & 3] |= f2bf(o2) << sh; op[3][j & 3] |= f2bf(o3) << sh; }
              else { const size_t tt = (size_t)(8 * F.tid + j);
                  const int sh = (j >> 2) * 16;
                  *(unsigned*)(YH + ((size_t)0 * SEQ + tt) * DM + c0) = ((op[0][j & 3] >> sh) & 0xffffu) | (f2bf(o0) << 16); *(unsigned*)(YH + ((size_t)1 * SEQ + tt) * DM + c0) = ((op[1][j & 3] >> sh) & 0xffffu) | (f2bf(o1) << 16);
                  *(unsigned*)(YH + ((size_t)2 * SEQ + tt) * DM + c0) = ((op[2][j & 3] >> sh) & 0xffffu) | (f2bf(o2) << 16); *(unsigned*)(YH + ((size_t)3 * SEQ + tt) * DM + c0) = ((op[3][j & 3] >> sh) & 0xffffu) | (f2bf(o3) << 16); } } }
        __syncthreads();
        if (!with_ctx) continue;
        LAS float* kr = (LAS float*)(F.lds + LDS_X0);
        LAS f32x4* vv4 = (LAS f32x4*)(F.lds + LDS_X0 + 8192);
        LAS f32x4* zz4 = (LAS f32x4*)(F.lds + LDS_X0 + 12288);
        LAS f32x4* part = (LAS f32x4*)(F.lds + LDS_X0 + 16384);
        { const int ri = (512 - F.tid) & 511; kr[ri] = kf0; kr[ri + 512] = kf0; kr[1024 + ri] = kf1; kr[1024 + ri + 512] = kf1; }
        float zc[2];
#pragma unroll
        for (int e = 0; e < 2; ++e) ((LAS float*)vv4)[t * 4 + b0 + e] = cv[e];
        __syncthreads();
#define CTX_CONV(KR, SRC) do { f32x4 acc = (f32x4){0.f, 0.f, 0.f, 0.f}; \
          _Pragma("unroll 2") for (int s = 128 * hf; s < 128 * hf + 128; s += 8) { const LAS float* kp = (KR) + ((s - t) & 511); float k8[8]; f32x4 v8[8]; \
              _Pragma("unroll") for (int jj = 0; jj < 8; ++jj) { k8[jj] = kp[jj]; v8[jj] = (SRC)[s + jj]; } \
              FFT_PIN(); \
              _Pragma("unroll") for (int jj = 0; jj < 8; ++jj) acc += k8[jj] * v8[jj]; } \
          part[hf * 256 + t] = acc; } while (0)
        CTX_CONV(kr, vv4);
        __syncthreads();
#pragma unroll
        for (int e = 0; e < 2; ++e) { const float y = ((LAS float*)part)[t * 4 + b0 + e] + ((LAS float*)part)[(256 + t) * 4 + b0 + e];
            zc[e] = cx1[e] * (y + sk0 * cv[e]); ((LAS float*)zz4)[t * 4 + b0 + e] = zc[e]; }
        __syncthreads();
        CTX_CONV(kr + 1024, zz4);
#undef CTX_CONV
        __syncthreads();
#pragma unroll
        for (int e = 0; e < 2; ++e) { const float y = ((LAS float*)part)[t * 4 + b0 + e] + ((LAS float*)part)[(256 + t) * 4 + b0 + e];
            const unsigned o = f2bf(cx2[e] * (y + sk1 * zc[e]));
            if (which == 0) opc[e] = o; else *(unsigned*)(YH + (size_t)(ML + (b0 + e) * CTXL + t) * DM + c0) = opc[e] | (o << 16); }
    }
    __syncthreads();
}
constexpr int AT_TILE = 35840, AT_K = 0, AT_V = 17408, AT_RPB = 2 * AT_TILE, AT_ROPE = AT_RPB + 2048, AT_END = AT_ROPE + 16384;
constexpr float ATT_SCALE2 = 0.08838834764831845f * 1.4426950408889634f;
__device__ __forceinline__ void attn_load_rope(Frame& F) {
    const f32x2v* rope = (const f32x2v*)(F.ws + WS_ROPE); LAS f32x2v* R = (LAS f32x2v*)(F.lds + AT_ROPE);
    __syncthreads();
    for (int e = F.tid; e < 2048; e += NTHR) R[e] = rope[e];
    __syncthreads();
}
#define ATT_PIN() __builtin_amdgcn_sched_barrier(0)
struct AttnTileRegs { bf16x8 ka, kb, v0, v1; };
__device__ __forceinline__ void attn_unit(Frame& F, int l, int u) {
    asm volatile("" : "+v"(F.tid)); F.lane = F.tid & 63;
    const bf16* P = (const bf16*)(F.ws + WS_P); const bf16* UT = (const bf16*)(F.ws + WS_UT);
    int mode, b, h, qtok0, klo, khi, qcol, kcol, vrow, qr0 = 0; bf16* Y; bool has_sink = false; float sink2 = 0.f;
    if (u < 256) { mode = 0; int p, blk; if (u < 32) { p = u >> 1; blk = (u & 1) ? 15 : 0; } else { const int t = u - 32; p = t / 14; blk = 1 + (t - 14 * p); } b = p >> 2; h = p & 3; qtok0 = b * SEQ + blk * 256;
        const int lo = blk * 256 - 128, hi = blk * 256 + 384; klo = b * SEQ + (lo < 0 ? 0 : lo); khi = b * SEQ + (hi > SEQ ? SEQ : hi);
        qcol = P_SWQ + h * 128; kcol = P_SWK + (h >> 1) * 128; vrow = U_SWV + (h >> 1) * 128; Y = (bf16*)(F.ws + WS_Y) + Y_SW; has_sink = true; sink2 = INP(F, I_SINK)[l * 4 + h] * 1.4426950408889634f; }
    else if (u < 512) { mode = 1; const int v = u - 256; int p, rq; if (v < 32) { p = v >> 1; rq = (v & 1) ? 15 : 0; } else { const int t = v - 32; p = t / 14; rq = 1 + (t - 14 * p); } b = p >> 2; h = p & 3; qr0 = 4 * rq; qtok0 = b * SEQ + qr0 * 64;
        int rs0 = qr0 - 4; rs0 = rs0 < 0 ? 0 : (rs0 > 56 ? 56 : rs0); int rs3 = qr0 + 3 - 4; rs3 = rs3 < 0 ? 0 : (rs3 > 56 ? 56 : rs3);
        klo = b * SEQ + 64 * rs0; khi = b * SEQ + 64 * (rs3 + 8);
        qcol = P_NAQ + h * 128; kcol = P_NAK + h * 128; vrow = U_NAV + h * 128; Y = (bf16*)(F.ws + WS_Y) + Y_NA; }
    else { const int v = u - 512; b = v >> 3; const int hh = v & 7; qtok0 = ML + b * CTXL; klo = 0; khi = 0;
        if (hh < 4) { mode = 2; h = hh; qcol = P_NAQ + h * 128; kcol = P_NAK + h * 128; vrow = U_NAV + h * 128; Y = (bf16*)(F.ws + WS_Y) + Y_NA; }
        else { mode = 3; h = hh - 4; qcol = P_SWQ + h * 128; kcol = P_SWK + (h >> 1) * 128; vrow = U_SWV + (h >> 1) * 128; Y = (bf16*)(F.ws + WS_Y) + Y_SW; has_sink = true; sink2 = INP(F, I_SINK)[l * 4 + h] * 1.4426950408889634f; } }
    const int ctok0 = ML + b * CTXL;
    const int lane = F.lane, w = F.wave, n = lane & 15, q4 = lane >> 4;
    LAS unsigned char* lds = F.lds; const LAS f32x2v* ROPE = (const LAS f32x2v*)(lds + AT_ROPE); LAS float* RPB = (LAS float*)(lds + AT_RPB);
    const int nloc = (khi - klo) >> 6, ntile = 4 + nloc;
    const int skey = F.tid >> 3, scp = F.tid & 7, shalf = scp >> 2, sci = scp & 3, sd0 = shalf * 64 + sci * 8;
#define ATT_KTOK(ti) ((ti) < 4 ? ctok0 + 64 * (ti) : klo + 64 * ((ti) - 4))
#define ATT_ISSUE(R, ti) do { const int kt_ = ATT_KTOK(ti); const bf16* kp_ = P + (size_t)(kt_ + skey) * NP + kcol + sd0; (R).ka = *(const bf16x8*)kp_; (R).kb = *(const bf16x8*)(kp_ + 32); \
        (R).v0 = *(const bf16x8*)(UT + (size_t)(vrow + (F.tid >> 3)) * MT + kt_ + 8 * (F.tid & 7)); (R).v1 = *(const bf16x8*)(UT + (size_t)(vrow + 64 + (F.tid >> 3)) * MT + kt_ + 8 * (F.tid & 7)); } while (0)
#define ATT_WRITE(R, ti, bufo) do { if (mode == 0 && (ti) >= 4) { const int tk_ = (ATT_KTOK(ti) + skey) & (SEQ - 1); const int pos_ = shalf == 0 ? (tk_ >> 6) : (tk_ & 63); \
            _Pragma("unroll") for (int j = 0; j < 8; ++j) { const f32x2v cs = ROPE[pos_ * 32 + 8 * sci + j]; const float x1 = bf2f((bf16)(R).ka[j]), x2 = bf2f((bf16)(R).kb[j]); \
                (R).ka[j] = (short)f2bf(x1 * cs.x - x2 * cs.y); (R).kb[j] = (short)f2bf(x2 * cs.x + x1 * cs.y); } } \
        *(LAS bf16x8*)(lds + (bufo) + AT_K + skey * 272 + sd0 * 2) = (R).ka; *(LAS bf16x8*)(lds + (bufo) + AT_K + skey * 272 + sd0 * 2 + 64) = (R).kb; \
        *(LAS bf16x8*)(lds + (bufo) + AT_V + (F.tid >> 3) * 144 + (F.tid & 7) * 16) = (R).v0; *(LAS bf16x8*)(lds + (bufo) + AT_V + (64 + (F.tid >> 3)) * 144 + (F.tid & 7) * 16) = (R).v1; } while (0)
    AttnTileRegs R;
    ATT_ISSUE(R, 0);
    __syncthreads();
    if (mode == 1) { const float* rpb = INP(F, I_RPB) + (size_t)(l * 4 + h) * 15 * 31; for (int e = F.tid; e < 465; e += NTHR) RPB[e] = rpb[e] * 1.4426950408889634f; }
    const int wq0 = qtok0 + 32 * w;
    bf16x8 qf[2][4];
#pragma unroll
    for (int g = 0; g < 2; ++g) { const int qtok = wq0 + 16 * g + n; const bf16* qp = P + (size_t)qtok * NP + qcol + 8 * q4;
#pragma unroll
      for (int s = 0; s < 4; ++s) qf[g][s] = *(const bf16x8*)(qp + 32 * s);
      if (mode == 0) {
          const int tq = qtok & (SEQ - 1);
#pragma unroll
          for (int ax = 0; ax < 2; ++ax) { const int pos = ax == 0 ? (tq >> 6) : (tq & 63);
#pragma unroll
              for (int j = 0; j < 8; ++j) { const f32x2v cs = ROPE[pos * 32 + 8 * q4 + j];
                  const float x1 = bf2f((bf16)qf[g][2 * ax][j]), x2 = bf2f((bf16)qf[g][2 * ax + 1][j]);
                  qf[g][2 * ax][j] = (short)f2bf(x1 * cs.x - x2 * cs.y); qf[g][2 * ax + 1][j] = (short)f2bf(x2 * cs.x + x1 * cs.y); } } }
    }
    ATT_WRITE(R, 0, 0);
#pragma unroll
    for (int g = 0; g < 2; ++g)
#pragma unroll
        for (int s = 0; s < 4; ++s) { v4u t = __builtin_bit_cast(v4u, qf[g][s]); asm volatile("" : "+v"(t)); qf[g][s] = __builtin_bit_cast(bf16x8, t); }
    float m_run[2], lsum[2]; f32x4 o[2][8];
#pragma unroll
    for (int g = 0; g < 2; ++g) { m_run[g] = has_sink ? sink2 : -1e30f; lsum[g] = (has_sink && q4 == 0) ? 1.0f : 0.f;
#pragma unroll
        for (int d = 0; d < 8; ++d) o[g][d] = (f32x4){0.f, 0.f, 0.f, 0.f}; }
    const int qr = qr0 + (w >> 1);
    int rs = qr - 4; rs = rs < 0 ? 0 : (rs > 56 ? 56 : rs);
    __syncthreads();
    for (int ti = 0; ti < ntile; ++ti) {
        const bool is_ctx = ti < 4; const int ktok0 = ATT_KTOK(ti); const int bufo = (ti & 1) * AT_TILE;
        if (ti + 1 < ntile) ATT_ISSUE(R, ti + 1);
        bool active = true;
        int kr = 0;
        if (!is_ctx) {
            if (mode == 1) { kr = (ktok0 & (SEQ - 1)) >> 6; active = (kr >= rs) && (kr < rs + 8); }
            else if (mode == 0) active = (ktok0 <= wq0 + 31 + 128) && (ktok0 + 63 >= wq0 - 128);
        }
        if (active) {
            f32x4 sc[2][4];
            { bf16x8 kf[2][4];
              const LAS unsigned char* kbase = lds + bufo + AT_K + n * 272 + 16 * q4;
#pragma unroll
              for (int s = 0; s < 4; ++s) kf[0][s] = *(const LAS bf16x8*)(kbase + 64 * s);
#pragma unroll
              for (int kb = 0; kb < 4; ++kb) {
                  if (kb < 3) {
#pragma unroll
                      for (int s = 0; s < 4; ++s) kf[(kb + 1) & 1][s] = *(const LAS bf16x8*)(kbase + (kb + 1) * (16 * 272) + 64 * s); }
                  ATT_PIN();
                  f32x4 a0 = (f32x4){0.f, 0.f, 0.f, 0.f}, a1 = (f32x4){0.f, 0.f, 0.f, 0.f};
#pragma unroll
                  for (int s = 0; s < 4; ++s) { a0 = __builtin_amdgcn_mfma_f32_16x16x32_bf16(kf[kb & 1][s], qf[0][s], a0, 0, 0, 0); a1 = __builtin_amdgcn_mfma_f32_16x16x32_bf16(kf[kb & 1][s], qf[1][s], a1, 0, 0, 0); }
                  sc[0][kb] = a0; sc[1][kb] = a1;
                  ATT_PIN(); } }
            bf16x8 pf[2][2];
#pragma unroll
            for (int g = 0; g < 2; ++g) {
                const int qtok = wq0 + 16 * g + n;
                float tmax = -INFINITY;
                if (is_ctx || mode >= 2 || (mode == 0 && ktok0 >= wq0 - 97 && ktok0 <= wq0 + 65)) {
#pragma unroll
                    for (int kb = 0; kb < 4; ++kb)
#pragma unroll
                        for (int r = 0; r < 4; ++r) { const float v = sc[g][kb][r] * ATT_SCALE2; sc[g][kb][r] = v; tmax = fmaxf(tmax, v); }
                } else if (mode == 0) {
                    const int d0 = qtok - ktok0 - 4 * q4;
#pragma unroll
                    for (int kb = 0; kb < 4; ++kb)
#pragma unroll
                        for (int r = 0; r < 4; ++r) { const int dpos = d0 - (16 * kb + r); float v = sc[g][kb][r] * ATT_SCALE2; v = (dpos > 128 || dpos < -128) ? -INFINITY : v; sc[g][kb][r] = v; tmax = fmaxf(tmax, v); }
                } else {
                    const int qc = 32 * (w & 1) + 16 * g + n; int cs0 = qc - 8; cs0 = cs0 < 0 ? 0 : (cs0 > 48 ? 48 : cs0);
                    int e0 = 4 * q4 - cs0; asm volatile("" : "+v"(e0));
                    const LAS float* rb = RPB + (kr - qr + 7) * 31 + (4 * q4 - qc + 15);
                    float bias[4][4];
#pragma unroll
                    for (int kb = 0; kb < 4; ++kb)
#pragma unroll
                        for (int r = 0; r < 4; ++r) bias[kb][r] = rb[16 * kb + r];
#pragma unroll
                    for (int kb = 0; kb < 4; ++kb)
#pragma unroll
                        for (int r = 0; r < 4; ++r) { float v = sc[g][kb][r] * ATT_SCALE2 + bias[kb][r]; v = ((unsigned)(e0 + 16 * kb + r) >= 16u) ? -INFINITY : v; sc[g][kb][r] = v; tmax = fmaxf(tmax, v); }
                }
                tmax = fmaxf(tmax, __shfl_xor(tmax, 16)); tmax = fmaxf(tmax, __shfl_xor(tmax, 32));
                const float m_new = fmaxf(m_run[g], tmax); const float alpha = __builtin_amdgcn_exp2f(m_run[g] - m_new); m_run[g] = m_new;
                float ps = 0.f;
#pragma unroll
                for (int kb = 0; kb < 4; ++kb)
#pragma unroll
                    for (int r = 0; r < 4; ++r) { const float p = __builtin_amdgcn_exp2f(sc[g][kb][r] - m_new); sc[g][kb][r] = p; ps += p; }
                lsum[g] = lsum[g] * alpha + ps;
#pragma unroll
                for (int d = 0; d < 8; ++d) o[g][d] = o[g][d] * alpha;
#pragma unroll
                for (int s2 = 0; s2 < 2; ++s2) { v4u t; t.x = pk2(sc[g][2 * s2][0], sc[g][2 * s2][1]); t.y = pk2(sc[g][2 * s2][2], sc[g][2 * s2][3]); t.z = pk2(sc[g][2 * s2 + 1][0], sc[g][2 * s2 + 1][1]); t.w = pk2(sc[g][2 * s2 + 1][2], sc[g][2 * s2 + 1][3]);
                    pf[g][s2] = __builtin_bit_cast(bf16x8, t); }
            }
            { v2u vr[2][4];
              const LAS unsigned char* vbase = lds + bufo + AT_V + n * 144 + 8 * q4;
#pragma unroll
              for (int e = 0; e < 4; ++e) vr[0][e] = *(const LAS v2u*)(vbase + 64 * (e >> 1) + 32 * (e & 1));
#pragma unroll
              for (int d = 0; d < 8; ++d) {
                  if (d < 7) {
#pragma unroll
                      for (int e = 0; e < 4; ++e) vr[(d + 1) & 1][e] = *(const LAS v2u*)(vbase + (d + 1) * (16 * 144) + 64 * (e >> 1) + 32 * (e & 1)); }
                  ATT_PIN();
#pragma unroll
                  for (int s2 = 0; s2 < 2; ++s2) { v4u t; t.x = vr[d & 1][2 * s2].x; t.y = vr[d & 1][2 * s2].y; t.z = vr[d & 1][2 * s2 + 1].x; t.w = vr[d & 1][2 * s2 + 1].y; const bf16x8 vf = __builtin_bit_cast(bf16x8, t);
                      o[0][d] = __builtin_amdgcn_mfma_f32_16x16x32_bf16(vf, pf[0][s2], o[0][d], 0, 0, 0); o[1][d] = __builtin_amdgcn_mfma_f32_16x16x32_bf16(vf, pf[1][s2], o[1][d], 0, 0, 0); }
                  ATT_PIN(); } }
        }
        __syncthreads();
        if (ti + 1 < ntile) ATT_WRITE(R, ti + 1, ((ti + 1) & 1) * AT_TILE);
        __syncthreads();
    }
#undef ATT_KTOK
#undef ATT_ISSUE
#undef ATT_WRITE
#pragma unroll
    for (int g = 0; g < 2; ++g) { float lt = lsum[g]; lt += __shfl_xor(lt, 16); lt += __shfl_xor(lt, 32);
        const float inv = 1.0f / lt;
        bf16* yp = Y + (size_t)(wq0 + 16 * g + n) * DM + h * 128 + 4 * q4;
#pragma unroll
        for (int d = 0; d < 8; ++d) { v2u t; t.x = pk2(o[g][d][0] * inv, o[g][d][1] * inv); t.y = pk2(o[g][d][2] * inv, o[g][d][3] * inv); *(v2u*)(yp + 16 * d) = t; } }
}

__device__ __forceinline__ void act_fixup(Frame& F, int l, int mrows) {
    const float* HP = (const float*)(F.ws + WS_HALO); const float* HU = (const float*)(F.ws + WS_HALO + HALO_ONE); const float* HA = (const float*)(F.ws + WS_HALO + 2 * HALO_ONE);
    bf16* ACT = (bf16*)(F.ws + WS_ACT);
    const float* cw = INP(F, I_FCW) + (size_t)l * 3 * DFF;
    const int ntile = mrows / 256, nit = ntile * 2 * (DFF / 4);
    for (int it = F.bid * NTHR + F.tid; it < nit; it += F.G * NTHR) {
        const int c4 = it % (DFF / 4), pe = it / (DFF / 4), e = pe & 1, pm = pe >> 1, t0 = pm * 256, seqlen = t0 < ML ? SEQ : CTXL;
        const bool open = e == 0 ? (t0 % seqlen) != 0 : ((t0 + 256) % seqlen) != 0;
        if (!open) continue;
        const int j = 4 * c4; const size_t ho = ((size_t)pm * 2 + e) * DFF + j;
        const f32x4 pp = *(const f32x4*)(HP + ho), uu = *(const f32x4*)(HU + ho);
        const f32x4 nb = e == 0 ? *(const f32x4*)(HA + ((size_t)(pm - 1) * 2 + 1) * DFF + j) : *(const f32x4*)(HA + ((size_t)(pm + 1) * 2 + 0) * DFF + j);
        const f32x4 w = *(const f32x4*)(cw + (e == 0 ? 0 : 2 * DFF) + j);
        float r[4];
#pragma unroll
        for (int q = 0; q < 4; ++q) { const float pre = pp[q] + w[q] * nb[q]; r[q] = pre * pg8::sigmoid_f(pre) * uu[q]; }
        v2u o; o.x = pk2(r[0], r[1]); o.y = pk2(r[2], r[3]);
        *(v2u*)(ACT + (size_t)(t0 + (e ? 255 : 0)) * DFF + j) = o;
    }
}
#ifndef MK_PER_PHASE
#define MK_PER_PHASE 0
#endif
constexpr int PH_PER_LAYER = 10, N_PHASES = 1 + PH_PER_LAYER * DEPTH;
__device__ __forceinline__ int ufence(int v) { asm volatile("" : "+v"(v)); return __builtin_amdgcn_readfirstlane(v); }
__device__ __forceinline__ int opq(int v) { return ufence(v); }
struct Args { const float* in[25]; float* out; unsigned char* ws; int ph_lo, ph_hi; };
__global__ void __launch_bounds__(NTHR, 2) hybrid_fwd(Args args) {
    extern __shared__ __attribute__((aligned(16))) unsigned char lds[];
    Frame F;
    F.lds = (LAS unsigned char*)lds; F.ldsg = lds;
    F.MISC = (volatile LAS unsigned*)(F.lds + MISC_OFF);
    F.tid = threadIdx.x; F.lane = F.tid & 63; F.wave = __builtin_amdgcn_readfirstlane(F.tid >> 6);
    F.G = gridDim.x; F.bid = blockIdx.x;
    F.ws = args.ws; F.ctl = (gu32*)(args.ws + WS_CTL); F.karg = (unsigned long long)__builtin_amdgcn_kernarg_segment_ptr();
    for (int u = F.tid; u < (LDS_BYTES - MISC_OFF) / 4; u += NTHR) ((LAS unsigned*)(F.lds + MISC_OFF))[u] = 0u;
    __syncthreads();
    XcdBarrier bar; bar.bar = (unsigned*)(F.ctl + CW_BAR); bar.x = 0; bar.st = nullptr;
#if !MK_PER_PHASE
    bar = xcd_barrier_post((unsigned*)(F.ctl + CW_BAR), F.MISC + 8, F.tid);
#endif
    const int lo = args.ph_lo, hi = args.ph_hi;
    const int MTr = ufence(MT);
#ifndef PHMASK
#define PHMASK 0x7ff
#endif
#define IN(k) (lo <= (k) && (k) < hi)
#define PHON(j) (((PHMASK) >> (j)) & 1)
#ifndef DBLMASK
#define DBLMASK 0
#endif
#define REPS(j) ((((DBLMASK) >> (j)) & 1) ? 2 : 1)
#define SEAM(k) do { if (IN(k) && IN((k) + 1)) { XcdBarrier b2_ = bar; b2_.bar = (unsigned*)(F.ws + WS_CTL) + CW_BAR; xcd_barrier(b2_, F.tid); } } while (0)
#define FENCE() do { asm volatile("" : "+v"(F.tid)); F.lane = F.tid & 63; F.wave = __builtin_amdgcn_readfirstlane(F.tid >> 6); F.bid = ufence(F.bid); F.G = ufence(F.G); \
    { const unsigned long long w_ = (unsigned long long)F.ws; const unsigned lo_ = (unsigned)ufence((int)(unsigned)w_), hi_ = (unsigned)ufence((int)(unsigned)(w_ >> 32)); F.ws = (unsigned char*)(GAS unsigned char*)(((unsigned long long)hi_ << 32) | lo_); }\
    { const unsigned lo_ = (unsigned)ufence((int)(unsigned)F.karg), hi_ = (unsigned)ufence((int)(unsigned)(F.karg >> 32)); F.karg = ((unsigned long long)hi_ << 32) | lo_; } } while (0)
#define H ((bf16*)(F.ws + WS_H))
#define Pb ((bf16*)(F.ws + WS_P))
#define UT ((bf16*)(F.ws + WS_UT))
#define WIN ((bf16*)(F.ws + WS_WSET + (size_t)wset * WSET_BYTES + WO_WIN))
#define WBR ((bf16*)(F.ws + WS_WSET + (size_t)wset * WSET_BYTES + WO_WBR))
#define WOUT ((bf16*)(F.ws + WS_WSET + (size_t)wset * WSET_BYTES + WO_WOUT))
#define WUP ((bf16*)(F.ws + WS_WSET + (size_t)wset * WSET_BYTES + WO_WUP))
#define WDN ((bf16*)(F.ws + WS_WSET + (size_t)wset * WSET_BYTES + WO_WDN))
#define YY ((bf16*)(F.ws + WS_Y))
#define T1 ((bf16*)(F.ws + WS_T1))
#define T2 ((bf16*)(F.ws + WS_T2))
#define MM ((bf16*)(F.ws + WS_MM))
#define MIX ((float*)(F.ws + WS_MIX))
#define AU ((bf16*)(F.ws + WS_AU))
#define ACT ((bf16*)(F.ws + WS_ACT))
#define SLAB ((_Float16*)(F.ws + WS_UT))

    if (PHON(0) && IN(0)) { FENCE(); p0_modvec(F); __syncthreads(); p0_filter_mlp(F); }
    SEAM(0);
    for (int l = 0; l < DEPTH; ++l) {
        const int pb = 1 + PH_PER_LAYER * l;
        const int mrows = (l == DEPTH - 1) ? ML : MTr;
        const int wset = l & 1, kbuf = l & 1;
        if (PHON(1) && IN(pb + 0)) for (int rep_ = 0; rep_ < REPS(1); ++rep_) { FENCE(); p1_weights(F, l, wset); if (l == 0) { rows_first(F); p1_modcomb(F); } }
        SEAM(pb + 0);
        if (PHON(2) && IN(pb + 1)) {
            FENCE(); fft_twiddles(F);
            for (int rep_ = 0; rep_ < REPS(11); ++rep_)
            for (int pi = F.bid; pi < HYW / 2; pi += F.G) filter_pair(F, l, 2 * pi, kbuf);
            __syncthreads(); FENCE();
            for (int rep_ = 0; rep_ < REPS(2); ++rep_) {
            const int npart = (l == DEPTH - 1) ? 2 : 1; int cum = 0;
#pragma unroll 1
            for (int part = 0; part < npart; ++part) {
              FENCE();
              const int rows = opq(npart == 1 ? MT : (part == 0 ? ML : MC)), roff = (part == 0) ? 0 : ML, N1 = opq(part == 0 ? NP : P_NAQ), K1 = opq(DM);
              const int c = (F.bid + F.G - cum % F.G) % F.G; cum += (rows / 256) * (N1 / 256);
              pg8::Gemm g{H + (size_t)roff * DM, WIN, rows, N1, K1, K1, K1}; pg8::StaticOrder S; S.init(rows, N1, F.G, c); pg8::EpiBf16Gate E{Pb + (size_t)roff * NP, NP, P_GATE / 256};
              pg8::gemm_phase<pg8::EpiBf16Gate, pg8::StaticOrder, true, true>(F.lds, g, S, E, F.tid); }
#pragma unroll 1
            for (int part = 0; part < npart; ++part) {
              FENCE();
              const int toks = opq(npart == 1 ? MT : (part == 0 ? ML : MC)), toff = (part == 0) ? 0 : ML, choff = (part == 0) ? 0 : U_NAV, M2 = opq(part == 0 ? NU : NU - U_NAV), K2 = opq(DM);
              const int c = (F.bid + F.G - cum % F.G) % F.G; cum += (M2 / 256) * (toks / 256);
              pg8::Gemm g{WIN + (size_t)(NP + choff) * DM, H + (size_t)toff * DM, M2, toks, K2, K2, K2}; pg8::StaticOrder S; S.init(M2, toks, F.G, c); pg8::EpiBf16P E{UT + (size_t)choff * MT + toff, MT};
              pg8::gemm_phase<pg8::EpiBf16P, pg8::StaticOrder, true, true>(F.lds, g, S, E, F.tid); }
            }
        }
        SEAM(pb + 1);
        if (PHON(3) && IN(pb + 2)) {
            FENCE(); fft_twiddles(F);
            for (int rep_ = 0; rep_ < REPS(3); ++rep_)
            for (int pi = F.bid; pi < HYW / 2; pi += F.G) { const int s = pi >> 8, wv = pi & 255; const int pr = 64 * (wv & 7) + (wv >> 3) + 32 * s; hyena_pair(F, l, 2 * pr, kbuf, l + 1 < DEPTH); }
            FENCE(); attn_load_rope(F);
            for (int rep_ = 0; rep_ < REPS(12); ++rep_)
            { const int vcu = (F.G % 8 == 0) ? (F.bid % 8) * (F.G / 8) + F.bid / 8 : F.bid;
              for (int u = vcu; u < (l + 1 < DEPTH ? 544 : 512); u += F.G) attn_unit(F, l, u); }
        }
        SEAM(pb + 2);
        if (PHON(4) && IN(pb + 3)) for (int rep_ = 0; rep_ < REPS(4); ++rep_) {
            FENCE();
            { pg8::Gemm g{YY, WBR, mrows, DM, opq(DM), DM, DM}; pg8::StaticOrder S; S.init(mrows, DM, F.G, F.bid); pg8::EpiMergeK E{Pb + P_GATE, NP, MM, DM};
              pg8::gemm_phase<pg8::EpiMergeK, pg8::StaticOrder, true, true>(F.lds, g, S, E, F.tid); }
        }
        SEAM(pb + 3);
        if (PHON(5) && IN(pb + 4)) for (int rep_ = 0; rep_ < REPS(5); ++rep_) { FENCE();
            { pg8::Gemm g{MM, WOUT, ML, DM, DM, DM, DM}; pg8::StaticOrder S; S.init(ML, DM, F.G, F.bid); pg8::EpiBf16P E{(bf16*)MIX, DM};
              pg8::gemm_phase<pg8::EpiBf16P, pg8::StaticOrder, true, true>(F.lds, g, S, E, F.tid); }
            if (mrows > ML) { FENCE();
              pg8::Gemm g{MM + (size_t)ML * DM, WOUT, MC, DM, opq(DM / 4), DM, DM}; pg8::SplitOrder S; S.init(MC, DM, 4, F.G, F.bid); pg8::EpiF32Slab E{SLAB, DM, (size_t)MC * DM};
              pg8::gemm_phase<pg8::EpiF32Slab, pg8::SplitOrder, true, true>(F.lds, g, S, E, F.tid); } }
        SEAM(pb + 4);
        if (PHON(6) && IN(pb + 5)) { FENCE(); rows_residual(F, l, MIX, 0, mrows, l == 0, false); }
        SEAM(pb + 5);
        if (PHON(7) && IN(pb + 6)) for (int rep_ = 0; rep_ < REPS(7); ++rep_) { FENCE(); pg8::StaticOrder S; S.init(mrows, 2 * DFF, F.G, F.bid);
            pg8::EpiAct E{ACT, DFF, INP(F, I_FCW) + (size_t)l * 3 * DFF, INP(F, I_FCB) + (size_t)l * DFF, (float*)(F.ws + WS_HALO), (float*)(F.ws + WS_HALO + HALO_ONE), (float*)(F.ws + WS_HALO + 2 * HALO_ONE)};
#pragma unroll 1
            for (int ui = 0; ; ++ui) { pg8::OneUnit S1; if (!S.next(ui, S1.u)) break;
                pg8::Gemm g{H, WUP, mrows, 2 * DFF, opq(DM), DM, DM};
                pg8::gemm_phase<pg8::EpiAct, pg8::OneUnit, false, true>(F.lds, g, S1, E, F.tid); __syncthreads(); } }
        SEAM(pb + 6);
        if (PHON(8) && IN(pb + 7)) for (int rep_ = 0; rep_ < REPS(8); ++rep_) { FENCE(); act_fixup(F, l, mrows); }
        SEAM(pb + 7);
        if (PHON(9) && IN(pb + 8)) for (int rep_ = 0; rep_ < REPS(9); ++rep_) { FENCE();
            { pg8::Gemm g{ACT, WDN, ML, DM, DFF, DFF, DFF}; pg8::StaticOrder S; S.init(ML, DM, F.G, F.bid); pg8::EpiBf16P E{(bf16*)MIX, DM};
              pg8::gemm_phase<pg8::EpiBf16P, pg8::StaticOrder, true, true>(F.lds, g, S, E, F.tid); }
            if (mrows > ML) { FENCE();
              pg8::Gemm g{ACT + (size_t)ML * DFF, WDN, MC, DM, opq(DFF / 4), DFF, DFF}; pg8::SplitOrder S; S.init(MC, DM, 4, F.G, F.bid); pg8::EpiF32Slab E{SLAB, DM, (size_t)MC * DM};
              pg8::gemm_phase<pg8::EpiF32Slab, pg8::SplitOrder, true, true>(F.lds, g, S, E, F.tid); } }
        SEAM(pb + 8);
        if (PHON(10) && IN(pb + 9)) { FENCE(); rows_residual(F, l, MIX, 1, mrows, false, l + 1 == DEPTH); }
        SEAM(pb + 9);
    }
#undef IN
#undef SEAM
#undef H
#undef Pb
#undef UT
#undef WIN
#undef WBR
#undef WOUT
#undef WUP
#undef WDN
#undef YY
#undef T1
#undef T2
#undef MM
#undef MIX
#undef AU
#undef ACT
#undef SLAB
}

extern "C" void kernel_launch(void* const* d_in, const int* in_sizes, int n_in, void* d_out, int out_size, void* d_ws, size_t ws_size, hipStream_t stream) {
    static int grid = 0;
    if (grid == 0) {
        if (n_in != 25 || in_sizes[0] != ML * DM || out_size != ML * DM || ws_size < WS_END) { fprintf(stderr, "kernel_launch: unexpected shapes (n_in %d, in0 %d, out %d, ws %zu < %zu); nothing launched\n", n_in, n_in > 0 ? in_sizes[0] : -1, out_size, ws_size, (size_t)WS_END); grid = -1; return; }
        int dev = 0, cus = 0, per_cu = 0;
        if (hipGetDevice(&dev) != hipSuccess || hipDeviceGetAttribute(&cus, hipDeviceAttributeMultiprocessorCount, dev) != hipSuccess) { fprintf(stderr, "kernel_launch: device query failed\n"); grid = -1; return; }
        if (hipFuncSetAttribute((const void*)hybrid_fwd, hipFuncAttributeMaxDynamicSharedMemorySize, LDS_BYTES) != hipSuccess) { fprintf(stderr, "kernel_launch: hipFuncSetAttribute failed\n"); grid = -1; return; }
        if (hipOccupancyMaxActiveBlocksPerMultiprocessor(&per_cu, (const void*)hybrid_fwd, NTHR, LDS_BYTES) != hipSuccess || per_cu < 1) fprintf(stderr, "kernel_launch: note: occupancy query reports %d blocks per CU\n", per_cu);
        (void)hipGetLastError();
        grid = cus;
    }
    if (grid < 0) return;
    if (hipMemsetAsync((char*)d_ws + WS_CTL, 0, CTL_ZERO_BYTES, stream) != hipSuccess) { fprintf(stderr, "kernel_launch: memset failed\n"); return; }
    Args a{};
    for (int i = 0; i < 25; ++i) a.in[i] = (const float*)d_in[i];
    a.out = (float*)d_out; a.ws = (unsigned char*)d_ws;
#if MK_PER_PHASE
    for (int p = 0; p < N_PHASES; ++p) { a.ph_lo = p; a.ph_hi = p + 1; hipLaunchKernelGGL(hybrid_fwd, dim3(grid), dim3(NTHR), LDS_BYTES, stream, a); }
#else
    a.ph_lo = 0; a.ph_hi = N_PHASES; hipLaunchKernelGGL(hybrid_fwd, dim3(grid), dim3(NTHR), LDS_BYTES, stream, a);
#endif
    const hipError_t le = hipPeekAtLastError();
    if (le != hipSuccess) fprintf(stderr, "kernel_launch: launch failed: %s\n", hipGetErrorName(le));
}
```
